# Optimizing an MI355X kernel written in HIP

```python
import math
import jax, jax.numpy as jnp
from jax import lax
import numpy as np

D_MODEL = 1024
BATCH = 4
SEQ = 8192
DEPTH = 2

HEAD_DIM = 64
ROPE_THETA = 10000.0
NORM_EPS = 1e-6
Q_BLOCK = 128
BIG = 1e9

NSA_HEADS = 8
NSA_KV_GROUPS = 2
NSA_HEADS_PER_GROUP = NSA_HEADS // NSA_KV_GROUPS
CMP_BLOCK = 32
CMP_STRIDE = 16
CMP_HIDDEN = 256
SLC_BLOCK = 64
SLC_TOPK = 16
WINDOW = 512
NSA_WIDTH = NSA_HEADS * HEAD_DIM
NSA_KV_WIDTH = NSA_KV_GROUPS * HEAD_DIM

DIFF_HEADS = 4
DIFF_QK_WIDTH = DIFF_HEADS * 2 * HEAD_DIM
DIFF_V_DIM = 2 * HEAD_DIM
DIFF_WIDTH = DIFF_HEADS * DIFF_V_DIM

SGU_CHUNK = 128
SGU_GROUPS = 4
SGU_WIDTH = 512
SGU_GROUP_DIM = SGU_WIDTH // SGU_GROUPS

N_BRANCHES = 3
BRANCH_WIDTH = 512
D_FF = -(-8 * D_MODEL // (3 * 256)) * 256

IN_SPLITS = [NSA_WIDTH, 6 * NSA_KV_WIDTH, NSA_HEADS * 3,
             DIFF_QK_WIDTH, DIFF_QK_WIDTH, DIFF_WIDTH, 2 * SGU_WIDTH]
D_IN = sum(IN_SPLITS)
IN_OFFSETS = [int(v) for v in np.cumsum(IN_SPLITS)[:-1]]

kernel_name = "hybrid_nsa_diffattn_sgu_block"


def rmsnorm(x, g):
    xf = x.astype(jnp.float32)
    y = xf * lax.rsqrt(jnp.mean(xf * xf, axis=-1, keepdims=True) + NORM_EPS)
    return y.astype(x.dtype) * g


def rope(x, positions):
    half = x.shape[-1] // 2
    inv_freq = ROPE_THETA ** (-jnp.arange(half, dtype=jnp.float32) / half)
    ang = positions.astype(jnp.float32)[..., None] * inv_freq
    cos = jnp.cos(ang)[:, :, None, :].astype(x.dtype)
    sin = jnp.sin(ang)[:, :, None, :].astype(x.dtype)
    x1, x2 = x[..., :half], x[..., half:]
    return jnp.concatenate([x1 * cos - x2 * sin, x2 * cos + x1 * sin], axis=-1)


def masked_softmax(logits, mask):
    lf = jnp.where(mask, logits.astype(jnp.float32), -1e30)
    p = jax.nn.softmax(lf, axis=-1)
    return jnp.where(mask, p, 0.0)


def map_query_blocks(fn, seq):
    out = lax.map(fn, jnp.arange(seq // Q_BLOCK))
    nb, b, t, w = out.shape
    return out.transpose(1, 0, 2, 3).reshape(b, nb * t, w)


def nsa_attention(q, k_cmp, v_cmp, k_slc, v_slc, k_win, v_win, gates, positions,
                  pos_k, wk1, wk2, pos_v, wv1, wv2):
    B, S = q.shape[:2]
    G, HPG, d = NSA_KV_GROUPS, NSA_HEADS_PER_GROUP, HEAD_DIM
    scale = d ** -0.5
    q_rot = rope(q, positions)
    k_slc = rope(k_slc, positions)
    k_win = rope(k_win, positions)

    n_cmp = (S - CMP_BLOCK) // CMP_STRIDE + 1
    cmp_idx = np.arange(n_cmp)[:, None] * CMP_STRIDE + np.arange(CMP_BLOCK)[None, :]
    cmp_end = jnp.asarray(np.arange(n_cmp) * CMP_STRIDE + CMP_BLOCK - 1)

    def compress(kv, pos_emb, w1, w2):
        blocks = kv[:, cmp_idx] + pos_emb[:, None, :]
        blocks = blocks.transpose(0, 1, 3, 2, 4).reshape(B, n_cmp, G, CMP_BLOCK * d)
        return jax.nn.gelu(blocks @ w1) @ w2

    kc = compress(k_cmp, pos_k, wk1, wk2)
    vc = compress(v_cmp, pos_v, wv1, wv2)

    n_slc = S // SLC_BLOCK
    slc_k = min(SLC_TOPK, n_slc)
    c_start = np.arange(n_cmp)[:, None] * CMP_STRIDE
    s_start = np.arange(n_slc)[None, :] * SLC_BLOCK
    overlap = jnp.asarray(((c_start < s_start + SLC_BLOCK) &
                           (c_start + CMP_BLOCK > s_start)).astype(np.float32))
    slc_starts = jnp.arange(n_slc) * SLC_BLOCK
    blk_ids = jnp.arange(n_slc)

    kb = k_slc.reshape(B, n_slc, SLC_BLOCK, G, d).transpose(0, 3, 1, 2, 4)
    vb = v_slc.reshape(B, n_slc, SLC_BLOCK, G, d).transpose(0, 3, 1, 2, 4)
    gather = jax.vmap(jax.vmap(lambda blocks, ids: blocks[ids]))

    k_win_pad = jnp.pad(k_win, ((0, 0), (WINDOW, 0), (0, 0), (0, 0)))
    v_win_pad = jnp.pad(v_win, ((0, 0), (WINDOW, 0), (0, 0), (0, 0)))

    def block(i):
        s0 = i * Q_BLOCK
        t = s0 + jnp.arange(Q_BLOCK)
        qg = lax.dynamic_slice_in_dim(q, s0, Q_BLOCK, axis=1).reshape(B, Q_BLOCK, G, HPG, d)
        qrg = lax.dynamic_slice_in_dim(q_rot, s0, Q_BLOCK, axis=1).reshape(B, Q_BLOCK, G, HPG, d)
        gb = lax.dynamic_slice_in_dim(gates, s0, Q_BLOCK, axis=1).reshape(B, Q_BLOCK, G, HPG, 3)

        logit_c = jnp.einsum('btghd,bngd->bghtn', qg, kc) * scale
        p_c = masked_softmax(logit_c, cmp_end[None, :] <= t[:, None])
        o_cmp = jnp.einsum('bghtn,bngd->btghd', p_c.astype(vc.dtype), vc)

        imp = jnp.einsum('bghtn,nj->bgtj', p_c, overlap)
        eligible = slc_starts[None, :] <= t[:, None]
        cur = t // SLC_BLOCK
        forced = (blk_ids[None, :] == 0) | (blk_ids[None, :] == cur[:, None]) | \
                 (blk_ids[None, :] == cur[:, None] - 1)
        score = jnp.where(forced, BIG, jnp.where(eligible, imp, -BIG))
        _, idx = lax.top_k(score, slc_k)
        ks = gather(kb, idx).reshape(B, G, Q_BLOCK, slc_k * SLC_BLOCK, d)
        vs = gather(vb, idx).reshape(B, G, Q_BLOCK, slc_k * SLC_BLOCK, d)
        kpos = (idx[..., None] * SLC_BLOCK + jnp.arange(SLC_BLOCK)).reshape(B, G, Q_BLOCK, slc_k * SLC_BLOCK)
        mask_s = (kpos <= t[None, None, :, None])[:, :, None]
        logit_s = jnp.einsum('btghd,bgtkd->bghtk', qrg, ks) * scale
        p_s = masked_softmax(logit_s, mask_s)
        o_slc = jnp.einsum('bghtk,bgtkd->btghd', p_s.astype(vs.dtype), vs)

        kw = lax.dynamic_slice_in_dim(k_win_pad, s0, Q_BLOCK + WINDOW, axis=1)
        vw = lax.dynamic_slice_in_dim(v_win_pad, s0, Q_BLOCK + WINDOW, axis=1)
        wpos = s0 - WINDOW + jnp.arange(Q_BLOCK + WINDOW)
        mask_w = (wpos[None, :] <= t[:, None]) & (wpos[None, :] > t[:, None] - WINDOW) & (wpos[None, :] >= 0)
        logit_w = jnp.einsum('btghd,bkgd->bghtk', qrg, kw) * scale
        p_w = masked_softmax(logit_w, mask_w)
        o_win = jnp.einsum('bghtk,bkgd->btghd', p_w.astype(vw.dtype), vw)

        out = gb[..., 0:1] * o_cmp + gb[..., 1:2] * o_slc + gb[..., 2:3] * o_win
        return out.reshape(B, Q_BLOCK, NSA_WIDTH)

    return map_query_blocks(block, S)


def diff_attention(q, k, v, positions, lq1, lk1, lq2, lk2, subln_g, lambda_init):
    B, S = q.shape[:2]
    scale = HEAD_DIM ** -0.5
    q = rope(q, positions)
    k = rope(k, positions)
    lam = (jnp.exp(jnp.sum(lq1 * lk1).astype(jnp.float32))
           - jnp.exp(jnp.sum(lq2 * lk2).astype(jnp.float32)) + lambda_init)
    kpos = jnp.arange(S)

    def block(i):
        s0 = i * Q_BLOCK
        t = s0 + jnp.arange(Q_BLOCK)
        qb = lax.dynamic_slice_in_dim(q, s0, Q_BLOCK, axis=1)
        logits = jnp.einsum('bthd,bshd->bhts', qb, k) * scale
        p = masked_softmax(logits, kpos[None, :] <= t[:, None])
        p = p.reshape(B, DIFF_HEADS, 2, Q_BLOCK, S)
        a = p[:, :, 0] - lam * p[:, :, 1]
        o = jnp.einsum('bhts,bshe->bthe', a.astype(v.dtype), v)
        o = rmsnorm(o, subln_g) * (1.0 - lambda_init)
        return o.reshape(B, Q_BLOCK, DIFF_WIDTH)

    return map_query_blocks(block, S)


def chunked_sgu(uv, norm_g, w_s, b_s):
    B, S = uv.shape[:2]
    z = jax.nn.gelu(uv)
    u, v = z[..., :SGU_WIDTH], z[..., SGU_WIDTH:]
    v = rmsnorm(v, norm_g).reshape(B, S // SGU_CHUNK, SGU_CHUNK, SGU_GROUPS, SGU_GROUP_DIM)
    causal = jnp.tril(jnp.ones((SGU_CHUNK, SGU_CHUNK), dtype=bool))
    w = jnp.where(causal[None], w_s, 0.0)
    s = jnp.einsum('gts,bnsgc->bntgc', w, v) + b_s.T[:, :, None]
    return u * s.reshape(B, S, SGU_WIDTH)


def setup_inputs(seed: int = 0) -> dict:
    key = jax.random.key(seed)
    ks = iter(jax.random.split(key, 40))
    L, D, d = DEPTH, D_MODEL, HEAD_DIM

    def normal(shape, scale):
        return jax.random.normal(next(ks), shape, jnp.float32) * scale

    def gain(shape):
        return 1.0 + normal(shape, 0.05)

    x = normal((BATCH, SEQ, D), 1.0)
    offset = jax.random.randint(next(ks), (BATCH, 1), 0, 4096, dtype=jnp.int32)
    positions = offset + jnp.arange(SEQ, dtype=jnp.int32)[None, :]
    return {
        "x": x,
        "positions": positions,
        "attn_norm": gain((L, D)),
        "w_in": normal((L, D, D_IN), D ** -0.5),
        "cmp_pos_k": normal((L, CMP_BLOCK, d), 0.1),
        "cmp_k_w1": normal((L, CMP_BLOCK * d, CMP_HIDDEN), (CMP_BLOCK * d) ** -0.5),
        "cmp_k_w2": normal((L, CMP_HIDDEN, d), CMP_HIDDEN ** -0.5),
        "cmp_pos_v": normal((L, CMP_BLOCK, d), 0.1),
        "cmp_v_w1": normal((L, CMP_BLOCK * d, CMP_HIDDEN), (CMP_BLOCK * d) ** -0.5),
        "cmp_v_w2": normal((L, CMP_HIDDEN, d), CMP_HIDDEN ** -0.5),
        "diff_lq1": normal((L, d), 0.1),
        "diff_lk1": normal((L, d), 0.1),
        "diff_lq2": normal((L, d), 0.1),
        "diff_lk2": normal((L, d), 0.1),
        "diff_subln": gain((L, DIFF_V_DIM)),
        "sgu_norm": gain((L, SGU_WIDTH)),
        "sgu_w": normal((L, SGU_GROUPS, SGU_CHUNK, SGU_CHUNK), 0.5 * SGU_CHUNK ** -0.5),
        "sgu_b": 1.0 + normal((L, SGU_GROUPS, SGU_CHUNK), 0.1),
        "w_branch_a": normal((L, NSA_WIDTH, D), NSA_WIDTH ** -0.5),
        "w_branch_b": normal((L, DIFF_WIDTH, D), DIFF_WIDTH ** -0.5),
        "w_branch_c": normal((L, SGU_WIDTH, D), SGU_WIDTH ** -0.5),
        "w_merge": normal((L, D, N_BRANCHES * D), D ** -0.5),
        "b_merge": normal((L, N_BRANCHES * D), 0.02),
        "w_out": normal((L, D, D), D ** -0.5),
        "ffn_norm": gain((L, D)),
        "w_ffn1": normal((L, D, D_FF), D ** -0.5),
        "w_ffn3": normal((L, D, D_FF), D ** -0.5),
        "w_ffn2": normal((L, D_FF, D), D_FF ** -0.5),
        "final_norm": gain((D,)),
    }


def reference(x, positions, attn_norm, w_in, cmp_pos_k, cmp_k_w1, cmp_k_w2, cmp_pos_v, cmp_v_w1,
              cmp_v_w2, diff_lq1, diff_lk1, diff_lq2, diff_lk2, diff_subln, sgu_norm, sgu_w, sgu_b,
              w_branch_a, w_branch_b, w_branch_c, w_merge, b_merge, w_out, ffn_norm, w_ffn1,
              w_ffn3, w_ffn2, final_norm):
    B, S, D = x.shape
    for l in range(DEPTH):
        lambda_init = 0.8 - 0.6 * math.exp(-0.3 * l)
        h = rmsnorm(x, attn_norm[l])
        proj = h @ w_in[l]
        q_a, kv_a, g_a, q_b, k_b, v_b, uv_c = jnp.split(proj, IN_OFFSETS, axis=-1)
        k_cmp, v_cmp, k_slc, v_slc, k_win, v_win = [
            t.reshape(B, S, NSA_KV_GROUPS, HEAD_DIM) for t in jnp.split(kv_a, 6, axis=-1)]
        o_a = nsa_attention(q_a.reshape(B, S, NSA_HEADS, HEAD_DIM), k_cmp, v_cmp, k_slc, v_slc,
                            k_win, v_win, jax.nn.sigmoid(g_a).reshape(B, S, NSA_HEADS, 3), positions,
                            cmp_pos_k[l], cmp_k_w1[l], cmp_k_w2[l], cmp_pos_v[l], cmp_v_w1[l], cmp_v_w2[l])
        o_b = diff_attention(q_b.reshape(B, S, 2 * DIFF_HEADS, HEAD_DIM),
                             k_b.reshape(B, S, 2 * DIFF_HEADS, HEAD_DIM),
                             v_b.reshape(B, S, DIFF_HEADS, DIFF_V_DIM), positions,
                             diff_lq1[l], diff_lk1[l], diff_lq2[l], diff_lk2[l], diff_subln[l], lambda_init)
        o_c = chunked_sgu(uv_c, sgu_norm[l], sgu_w[l], sgu_b[l])
        gates = jax.nn.sigmoid(h @ w_merge[l] + b_merge[l]).reshape(B, S, N_BRANCHES, D)
        mixed = (gates[:, :, 0] * (o_a @ w_branch_a[l])
                 + gates[:, :, 1] * (o_b @ w_branch_b[l])
                 + gates[:, :, 2] * (o_c @ w_branch_c[l]))
        x = x + mixed @ w_out[l]
        h = rmsnorm(x, ffn_norm[l])
        x = x + (jax.nn.silu(h @ w_ffn1[l]) * (h @ w_ffn3[l])) @ w_ffn2[l]
    return rmsnorm(x, final_norm)
```

```cpp
#include <hip/hip_runtime.h>
#include <hip/hip_cooperative_groups.h>
#include <hip/hip_bf16.h>
#include <cstdio>
#include <cstdint>
#include <cmath>
namespace cg = cooperative_groups;
namespace pg8 {
#define PG8_LAS __attribute__((address_space(3)))
typedef unsigned short bf16_t;
typedef short bf16x8 __attribute__((ext_vector_type(8)));
typedef float f32x4 __attribute__((ext_vector_type(4)));
typedef unsigned u32x4 __attribute__((ext_vector_type(4)));
constexpr int BM = 256, BK = 64, HALF = 128, HTB = HALF * BK * 2  , STAGE_BYTES = 8 * HTB, NXCD = 8, WGM = 8;

__host__ __device__ __forceinline__ int lds_byte(int r, int c) { const int st = (r >> 4) * 2 + (c >> 5), rr = r & 15, cc = c & 31, ob = rr * 64 + cc * 2; return st * 1024 + (ob ^ (((ob >> 9) & 1) << 5)); }
__host__ __device__ __forceinline__ void stage_rc(int b, int& R, int& C) { const int st = b / 1024, sb = b % 1024, swz = sb ^ (((sb >> 9) & 1) << 5); R = (st >> 1) * 16 + swz / 64; C = (st & 1) * 32 + (swz % 64) / 2; }
__host__ __device__ __forceinline__ int perm32(int rho) { const int n = rho >> 4, i = rho & 15; return 8 * (i >> 2) + 4 * n + (i & 3); }

struct Unit { int pm, pn; };
struct Gemm { const bf16_t* A; const bf16_t* Bt; int M, N, K; };

struct StaticOrder {
    int nM, nN, nwg, G, c;
    __host__ __device__ void init(int M, int N, int G_, int c_) { nM = M / BM; nN = N / BM; nwg = nM * nN; G = G_; c = c_; }
    __host__ __device__ bool next(int i, Unit& u) const {
        const long L = (long)i * G + c; if (L >= nwg) return false;
        int wgid = (int)L; { const int q = nwg / NXCD, r = nwg % NXCD, xcd = wgid % NXCD, off = wgid / NXCD; wgid = (xcd < r ? xcd * (q + 1) : r * (q + 1) + (xcd - r) * q) + off; }
        const int nig = WGM * nN, gid = wgid / nig, fm = gid * WGM, gsz = (nM - fm) < WGM ? (nM - fm) : WGM;
        u.pm = fm + ((wgid % nig) % gsz); u.pn = (wgid % nig) / gsz; return true;
    }
    __device__ __forceinline__ void a_ready(const Unit&) const {}
    __device__ __forceinline__ void done(const Unit&) const {}
};

__device__ __forceinline__ unsigned cvt_pk_bf16(float lo, float hi) { unsigned r; asm volatile("v_cvt_pk_bf16_f32 %0, %1, %2" : "=v"(r) : "v"(lo), "v"(hi)); return r; }
typedef unsigned u32x2 __attribute__((ext_vector_type(2)));
__device__ __forceinline__ float bf_lo(unsigned w) { return __uint_as_float(w << 16); }
__device__ __forceinline__ float bf_hi(unsigned w) { return __uint_as_float(w & 0xffff0000u); }
__device__ __forceinline__ float fast_sigmoid(float x) { return __builtin_amdgcn_rcpf(1.0f + __builtin_amdgcn_exp2f(-1.4426950408889634f * x)); }
__device__ __forceinline__ float gelu_tanh(float x) { const float z = 0.7978845608028654f * (x + 0.044715f * x * x * x); return x * __builtin_amdgcn_rcpf(1.0f + __builtin_amdgcn_exp2f(-2.885390081777927f * z)); }
__device__ __forceinline__ u32x4 pack8(const f32x4& a, const f32x4& b) { u32x4 w; w.x = cvt_pk_bf16(a[0], a[1]); w.y = cvt_pk_bf16(a[2], a[3]); w.z = cvt_pk_bf16(b[0], b[1]); w.w = cvt_pk_bf16(b[2], b[3]); return w; }

struct EpiG1 {
    static constexpr bool PERM = true, AFTER_DRAIN = false, KEEPS = false;
    bf16_t *qa, *kcmp, *vcmp, *kslc, *vslc, *kwin, *vwin, *qb, *kb, *vb, *uu, *vv; unsigned char* gates; float* ga;
    const float* bmerge; const float* cosT; const float* sinT; float c2;
    __device__ __forceinline__ void operator()(const f32x4 (&acc)[2][2][4][2], const Unit& u, int wr, int wc, int fr, int fq) const {
        const int pn = u.pn; const int row0 = u.pm * BM + wr * 64 + fr; const int lc = wc * 32 + 8 * fq;
#pragma unroll
        for (int bj = 0; bj < 2; ++bj) {
            int mode = 0; bf16_t* dst = qa; int pitch = 512, colb = 0; float sc = 1.f;
            if (pn < 2) { dst = qa; colb = pn * 256 + bj * 128; sc = c2; }
            else if (pn == 2) { dst = bj ? vcmp : kcmp; pitch = 128; }
            else if (pn == 3) { dst = bj ? vslc : kslc; pitch = 128; mode = bj ? 0 : 1; }
            else if (pn == 4) { dst = bj ? vwin : kwin; pitch = 128; mode = bj ? 0 : 1; }
            else if (pn < 7) { dst = qb; colb = (pn - 5) * 256 + bj * 128; sc = c2; mode = 1; }
            else if (pn < 9) { dst = kb; colb = (pn - 7) * 256 + bj * 128; mode = 1; }
            else if (pn < 11) { dst = vb; colb = (pn - 9) * 256 + bj * 128; }
            else if (pn < 13) { dst = uu; colb = (pn - 11) * 256 + bj * 128; mode = 2; }
            else if (pn < 15) { dst = vv; colb = (pn - 13) * 256 + bj * 128; mode = 2; }
            else if (pn < 27) { colb = (pn - 15) * 256 + bj * 128; mode = 3; }
            else mode = 4;
            const int col = colb + lc;
            if (mode == 0) {
#pragma unroll
                for (int ai = 0; ai < 2; ++ai)
#pragma unroll
                    for (int m = 0; m < 4; ++m) { const int row = row0 + ai * HALF + m * 16;
                        *(u32x4*)(dst + (size_t)row * pitch + col) = pack8(acc[ai][bj][m][0] * sc, acc[ai][bj][m][1] * sc); }
            } else if (mode == 1) {
                const int g8 = (lc & 63) >> 3;
#pragma unroll
                for (int ai = 0; ai < 2; ++ai)
#pragma unroll
                    for (int m = 0; m < 4; ++m) { const int row = row0 + ai * HALF + m * 16;
                        const f32x4 c = *(const f32x4*)(cosT + (size_t)row * 32 + 4 * g8), s = *(const f32x4*)(sinT + (size_t)row * 32 + 4 * g8);
                        const f32x4 x1 = acc[ai][bj][m][0], x2 = acc[ai][bj][m][1];
                        const f32x4 y1 = (x1 * c - x2 * s) * sc, y2 = (x2 * c + x1 * s) * sc;
                        *(u32x4*)(dst + (size_t)row * pitch + col) = pack8(y1, y2); }
            } else if (mode == 2) {
#pragma unroll
                for (int ai = 0; ai < 2; ++ai)
#pragma unroll
                    for (int m = 0; m < 4; ++m) { const int row = row0 + ai * HALF + m * 16; f32x4 a = acc[ai][bj][m][0], b = acc[ai][bj][m][1];
#pragma unroll
                        for (int k = 0; k < 4; ++k) { a[k] = gelu_tanh(a[k]); b[k] = gelu_tanh(b[k]); }
                        *(u32x4*)(dst + (size_t)row * pitch + col) = pack8(a, b); }
            } else if (mode == 3) {
                const f32x4 b0 = *(const f32x4*)(bmerge + col) * -1.4426950408889634f, b1 = *(const f32x4*)(bmerge + col + 4) * -1.4426950408889634f;
#pragma unroll
                for (int ai = 0; ai < 2; ++ai)
#pragma unroll
                    for (int m = 0; m < 4; ++m) { const int row = row0 + ai * HALF + m * 16; const f32x4 a = acc[ai][bj][m][0] * -1.4426950408889634f + b0, b = acc[ai][bj][m][1] * -1.4426950408889634f + b1;
                        unsigned lo = 0u, hi = 0u;
#pragma unroll
                        for (int k = 0; k < 4; ++k) { const float ea = __builtin_amdgcn_exp2f(a[k]), eb = __builtin_amdgcn_exp2f(b[k]);
                            const unsigned qa_ = (unsigned)__builtin_amdgcn_rcpf(ea * (1.0f / 255.99f) + (1.0f / 255.99f)), qb_ = (unsigned)__builtin_amdgcn_rcpf(eb * (1.0f / 255.99f) + (1.0f / 255.99f)); lo |= qa_ << (8 * k); hi |= qb_ << (8 * k); }
                        *(u32x2*)(gates + (size_t)row * 3072 + col) = (u32x2){lo, hi}; }
            } else {
                if (bj == 0 && lc < 24) {
#pragma unroll
                    for (int ai = 0; ai < 2; ++ai)
#pragma unroll
                        for (int m = 0; m < 4; ++m) { const int row = row0 + ai * HALF + m * 16; f32x4 a = acc[ai][bj][m][0], b = acc[ai][bj][m][1];
#pragma unroll
                            for (int k = 0; k < 4; ++k) { a[k] = fast_sigmoid(a[k]); b[k] = fast_sigmoid(b[k]); }
                            *(f32x4*)(ga + (size_t)row * 24 + lc) = a; *(f32x4*)(ga + (size_t)row * 24 + lc + 4) = b; }
                }
            }
        }
    }
};
struct BranchOrder {
    StaticOrder S;
    __device__ __forceinline__ bool next(int i, Unit& u) const { Unit t; const int r = i / 3, b = i - 3 * r; if (!S.next(r, t)) return false; u.pm = t.pm + (b == 0 ? 0 : b == 1 ? 320 : 704); u.pn = t.pn + 4 * b; return true; }
    __device__ __forceinline__ void a_ready(const Unit&) const {}
    __device__ __forceinline__ void done(const Unit&) const {}
};
struct EpiBranch {
    static constexpr bool PERM = true, AFTER_DRAIN = false, KEEPS = true;
    const unsigned char* gates; bf16_t* mixed;
    __device__ __forceinline__ bool keep(const Unit& u) const { return (u.pn >> 2) < 2; }
    __device__ __forceinline__ void run(f32x4 (&acc)[2][2][4][2], const Unit& uu_, int wr, int wc, int fr, int fq) const {
        const int b = uu_.pn >> 2; Unit u; u.pn = uu_.pn & 3; u.pm = uu_.pm - (b == 0 ? 0 : b == 1 ? 320 : 704);
        const int row0 = u.pm * BM + wr * 64 + fr;
#pragma unroll
        for (int bj = 0; bj < 2; ++bj) { const int col = u.pn * BM + bj * HALF + wc * 32 + 8 * fq;
#pragma unroll
            for (int ai = 0; ai < 2; ++ai)
#pragma unroll
                for (int m = 0; m < 4; ++m) { const int row = row0 + ai * HALF + m * 16;
                    const u32x2 gq = *(const u32x2*)(gates + (size_t)row * 3072 + b * 1024 + col);
                    f32x4 g0, g1;
#pragma unroll
                    for (int k = 0; k < 4; ++k) { g0[k] = ((float)((gq.x >> (8 * k)) & 255u) + 0.5f) * (1.0f / 256.0f); g1[k] = ((float)((gq.y >> (8 * k)) & 255u) + 0.5f) * (1.0f / 256.0f); }
                    if (b < 2) { const u32x2 gn = *(const u32x2*)(gates + (size_t)row * 3072 + (b + 1) * 1024 + col);
#pragma unroll
                        for (int k = 0; k < 4; ++k) { g0[k] *= __builtin_amdgcn_rcpf(((float)((gn.x >> (8 * k)) & 255u) + 0.5f) * (1.0f / 256.0f)); g1[k] *= __builtin_amdgcn_rcpf(((float)((gn.y >> (8 * k)) & 255u) + 0.5f) * (1.0f / 256.0f)); }
                        acc[ai][bj][m][0] *= g0; acc[ai][bj][m][1] *= g1; }
                    else *(u32x4*)(mixed + (size_t)row * 1024 + col) = pack8(acc[ai][bj][m][0] * g0, acc[ai][bj][m][1] * g1); }
        }
    }
};
struct EpiResid {
    static constexpr bool PERM = true, AFTER_DRAIN = false, KEEPS = false;
    const float* xin; float* xout;
    __device__ __forceinline__ void operator()(const f32x4 (&acc)[2][2][4][2], const Unit& u, int wr, int wc, int fr, int fq) const {
        const int row0 = u.pm * BM + wr * 64 + fr;
#pragma unroll
        for (int bj = 0; bj < 2; ++bj) { const int col = u.pn * BM + bj * HALF + wc * 32 + 8 * fq;
#pragma unroll
            for (int ai = 0; ai < 2; ++ai)
#pragma unroll
                for (int m = 0; m < 4; ++m) { const size_t off = (size_t)(row0 + ai * HALF + m * 16) * 1024 + col;
                    const f32x4 a = *(const f32x4*)(xin + off), b = *(const f32x4*)(xin + off + 4);
                    *(f32x4*)(xout + off) = a + acc[ai][bj][m][0]; *(f32x4*)(xout + off + 4) = b + acc[ai][bj][m][1]; }
        }
    }
};
struct EpiSwiGLU {
    static constexpr bool PERM = true, AFTER_DRAIN = false, KEEPS = false;
    bf16_t* hid;
    __device__ __forceinline__ void operator()(const f32x4 (&acc)[2][2][4][2], const Unit& u, int wr, int wc, int fr, int fq) const {
        const int row0 = u.pm * BM + wr * 64 + fr; const int col = u.pn * HALF + wc * 32 + 8 * fq;
#pragma unroll
        for (int ai = 0; ai < 2; ++ai)
#pragma unroll
            for (int m = 0; m < 4; ++m) { const int row = row0 + ai * HALF + m * 16; f32x4 a = acc[ai][0][m][0], b = acc[ai][0][m][1];
#pragma unroll
                for (int k = 0; k < 4; ++k) { a[k] = a[k] * fast_sigmoid(a[k]) * acc[ai][1][m][0][k]; b[k] = b[k] * fast_sigmoid(b[k]) * acc[ai][1][m][1][k]; }
                *(u32x4*)(hid + (size_t)row * 2816 + col) = pack8(a, b); }
    }
};
template <class Epi, class Sched, bool ALIGN_EPI = false, bool SP2 = false>
__device__ __forceinline__ void gemm_phase(PG8_LAS unsigned char* lds, const Gemm g, const Sched& S, const Epi& E) {
    int tid_ = threadIdx.x; asm volatile("" : "+v"(tid_)); const int tid = tid_, wid = __builtin_amdgcn_readfirstlane(tid >> 6), lane = tid & 63, wr = wid >> 2, wc = wid & 3, fr = lane & 15, fq = lane >> 4;
    const int K = g.K, nt = K / BK;
    unsigned voffA[2], voffB[2];
#pragma unroll
    for (int i = 0; i < 2; ++i) { int R, C; stage_rc(tid * 16 + i * 8192, R, C); const int Rb = Epi::PERM ? ((R & ~31) + perm32(R & 31)) : R;
        voffA[i] = (unsigned)(R * K + C) * 2u; voffB[i] = (unsigned)(Rb * K + C) * 2u; }
    const size_t kstep = (size_t)(BK * 2);
    const size_t hstep = (size_t)HALF * K * 2;
    const size_t tstep = 2 * hstep;
    const unsigned ldsw = (unsigned)wid * 1024u;
    const int aoff = lds_byte(wr * 64 + fr, fq * 8), boff = lds_byte(wc * 32 + fr, fq * 8);
#define PG8_SA(b, h) (((b) * 2 + (h)) * HTB)
#define PG8_SB(b, h) ((4 + (b) * 2 + (h)) * HTB)
#define PG8_STAGE(bufoff, gbase, voff) do { _Pragma("unroll") for (int _i = 0; _i < 2; ++_i) \
        __builtin_amdgcn_global_load_lds((const unsigned*)((const char*)(gbase) + (voff)[_i]), (PG8_LAS unsigned*)(lds + (bufoff) + ldsw + _i * 8192), 16, 0, 0); } while (0)
#define PG8_LDA(dst, b, h) do { _Pragma("unroll") for (int m = 0; m < 4; ++m) _Pragma("unroll") for (int k = 0; k < 2; ++k) dst[m][k] = *(const PG8_LAS bf16x8*)(lds + PG8_SA(b, h) + aoff + m * 2048 + k * 1024); } while (0)
#define PG8_LDB(dst, b, h) do { _Pragma("unroll") for (int n = 0; n < 2; ++n) _Pragma("unroll") for (int k = 0; k < 2; ++k) dst[n][k] = *(const PG8_LAS bf16x8*)(lds + PG8_SB(b, h) + boff + n * 2048 + k * 1024); } while (0)
#define PG8_MMA(ai, bj, At, Bt) do { __builtin_amdgcn_s_setprio(1); _Pragma("unroll") for (int m = 0; m < 4; ++m) _Pragma("unroll") for (int n = 0; n < 2; ++n) _Pragma("unroll") for (int k = 0; k < 2; ++k) \
        acc[ai][bj][m][n] = __builtin_amdgcn_mfma_f32_16x16x32_bf16(Bt[n][k], At[m][k], acc[ai][bj][m][n], 0, 0, 0); __builtin_amdgcn_s_setprio(0); } while (0)
#define PG8_WAIT_V(n) asm volatile("s_waitcnt vmcnt(" #n ")" ::: "memory")
#define PG8_WAIT_L(n) asm volatile("s_waitcnt lgkmcnt(" #n ")" ::: "memory")
#define PG8_BAR __builtin_amdgcn_s_barrier()
#define PG8_SCHED __builtin_amdgcn_sched_barrier(0)
    Unit cur, nxt; int ui = 0;
    if (!S.next(0, cur)) return;
    f32x4 acc[2][2][4][2];
#pragma unroll
    for (int a = 0; a < 2; ++a)
#pragma unroll
        for (int b = 0; b < 2; ++b)
#pragma unroll
            for (int m = 0; m < 4; ++m)
#pragma unroll
                for (int n = 0; n < 2; ++n) acc[a][b][m][n] = (f32x4){0.f, 0.f, 0.f, 0.f};
    bf16x8 At[4][2], B0[2][2], B1[2][2];
    const char* cA = (const char*)g.A + (size_t)cur.pm * tstep; const char* cB = (const char*)g.Bt + (size_t)cur.pn * tstep;
    S.a_ready(cur);
    if constexpr (SP2) {
        PG8_STAGE(PG8_SB(0, 0), cB, voffB); PG8_STAGE(PG8_SB(0, 1), cB + hstep, voffB); PG8_STAGE(PG8_SA(0, 0), cA, voffA); PG8_STAGE(PG8_SA(0, 1), cA + hstep, voffA);
        if (wr == 1) PG8_BAR;
        PG8_WAIT_V(2); PG8_BAR;
        PG8_STAGE(PG8_SB(1, 0), cB + kstep, voffB); PG8_STAGE(PG8_SA(1, 0), cA + kstep, voffA); PG8_STAGE(PG8_SB(1, 1), cB + hstep + kstep, voffB);
        PG8_WAIT_V(6); PG8_BAR;
    } else {
        PG8_STAGE(PG8_SB(0, 0), cB, voffB); PG8_STAGE(PG8_SA(0, 0), cA, voffA); PG8_STAGE(PG8_SB(0, 1), cB + hstep, voffB); PG8_STAGE(PG8_SA(0, 1), cA + hstep, voffA);
        if (wr == 1) PG8_BAR;
        PG8_WAIT_V(4); PG8_BAR;
        PG8_STAGE(PG8_SB(1, 0), cB + kstep, voffB); PG8_STAGE(PG8_SA(1, 0), cA + kstep, voffA); PG8_STAGE(PG8_SB(1, 1), cB + hstep + kstep, voffB);
        PG8_WAIT_V(6); PG8_BAR;
    }
    for (;;) {
        const bool has_next = S.next(ui + 1, nxt);
        const char* nA = has_next ? (const char*)g.A + (size_t)nxt.pm * tstep : cA; const char* nB = has_next ? (const char*)g.Bt + (size_t)nxt.pn * tstep : cB;
        for (int t = 0; t < nt; t += 2) {
            const bool last = (t == nt - 2);
            const char* a1 = cA + (size_t)(t + 1) * kstep;
            const char* a2 = last ? nA : cA + (size_t)(t + 2) * kstep; const char* b2 = last ? nB : cB + (size_t)(t + 2) * kstep;
            const char* a3 = a2 + kstep; const char* b3 = b2 + kstep;
            if (last && has_next) S.a_ready(nxt);
            if constexpr (SP2) {
            PG8_LDB(B0, 0, 0); PG8_LDB(B1, 0, 1); PG8_SCHED; PG8_LDA(At, 0, 0); PG8_STAGE(PG8_SA(1, 1), a1 + hstep, voffA);
            PG8_WAIT_V(8); PG8_WAIT_L(0); PG8_BAR; PG8_MMA(0, 0, At, B0); PG8_MMA(0, 1, At, B1); PG8_BAR; PG8_SCHED;
            PG8_LDA(At, 0, 1); PG8_STAGE(PG8_SB(0, 0), b2, voffB); PG8_STAGE(PG8_SB(0, 1), b2 + hstep, voffB); PG8_STAGE(PG8_SA(0, 0), a2, voffA);
            PG8_WAIT_V(8); PG8_WAIT_L(0); PG8_BAR; PG8_MMA(1, 0, At, B0); PG8_MMA(1, 1, At, B1); PG8_BAR; PG8_SCHED;
            PG8_LDB(B0, 1, 0); PG8_LDB(B1, 1, 1); PG8_SCHED; PG8_LDA(At, 1, 0); PG8_STAGE(PG8_SA(0, 1), a2 + hstep, voffA);
            PG8_WAIT_V(8); PG8_WAIT_L(0); PG8_BAR; PG8_MMA(0, 0, At, B0); PG8_MMA(0, 1, At, B1); PG8_BAR; PG8_SCHED;
            PG8_LDA(At, 1, 1); PG8_STAGE(PG8_SB(1, 0), b3, voffB); PG8_STAGE(PG8_SB(1, 1), b3 + hstep, voffB); PG8_STAGE(PG8_SA(1, 0), a3, voffA);
            PG8_WAIT_V(8); PG8_WAIT_L(0); PG8_BAR; PG8_MMA(1, 0, At, B0); PG8_MMA(1, 1, At, B1); PG8_BAR; PG8_SCHED;
            } else {
            PG8_LDB(B0, 0, 0); PG8_SCHED; PG8_LDA(At, 0, 0); PG8_STAGE(PG8_SA(1, 1), a1 + hstep, voffA);
            PG8_WAIT_L(8); PG8_BAR; PG8_WAIT_L(0); PG8_MMA(0, 0, At, B0); PG8_BAR; PG8_SCHED;
            PG8_LDB(B1, 0, 1); PG8_STAGE(PG8_SB(0, 0), b2, voffB);
            PG8_BAR; PG8_WAIT_L(0); PG8_MMA(0, 1, At, B1); PG8_BAR;
            PG8_LDA(At, 0, 1); PG8_STAGE(PG8_SA(0, 0), a2, voffA);
            PG8_BAR; PG8_WAIT_L(0); PG8_MMA(1, 0, At, B0); PG8_BAR; PG8_SCHED;
            PG8_STAGE(PG8_SB(0, 1), b2 + hstep, voffB);
            PG8_WAIT_V(6); PG8_BAR; PG8_MMA(1, 1, At, B1); PG8_BAR;
            PG8_LDB(B0, 1, 0); PG8_SCHED; PG8_LDA(At, 1, 0); PG8_STAGE(PG8_SA(0, 1), a2 + hstep, voffA);
            PG8_WAIT_L(8); PG8_BAR; PG8_WAIT_L(0); PG8_MMA(0, 0, At, B0); PG8_BAR; PG8_SCHED;
            PG8_LDB(B1, 1, 1); PG8_STAGE(PG8_SB(1, 0), b3, voffB);
            PG8_BAR; PG8_WAIT_L(0); PG8_MMA(0, 1, At, B1); PG8_BAR;
            PG8_LDA(At, 1, 1); PG8_STAGE(PG8_SA(1, 0), a3, voffA);
            PG8_BAR; PG8_WAIT_L(0); PG8_MMA(1, 0, At, B0); PG8_BAR; PG8_SCHED;
            PG8_STAGE(PG8_SB(1, 1), b3 + hstep, voffB);
            PG8_WAIT_V(6); PG8_BAR; PG8_MMA(1, 1, At, B1); PG8_BAR;
            }
        }
        if constexpr (ALIGN_EPI) { if (wr == 0) PG8_BAR; }
        bool keep_acc = false;
        if constexpr (Epi::KEEPS) { E.run(acc, cur, wr, wc, fr, fq); keep_acc = E.keep(cur); }
        else if constexpr (!Epi::AFTER_DRAIN) { E(acc, cur, wr, wc, fr, fq); S.done(cur); }
        if (!has_next) break;
        if (!keep_acc)
#pragma unroll
        for (int a = 0; a < 2; ++a)
#pragma unroll
            for (int b = 0; b < 2; ++b)
#pragma unroll
                for (int m = 0; m < 4; ++m)
#pragma unroll
                    for (int n = 0; n < 2; ++n) acc[a][b][m][n] = (f32x4){0.f, 0.f, 0.f, 0.f};
        cur = nxt; cA = nA; cB = nB; ++ui;
        if constexpr (ALIGN_EPI) { if (wr == 1) PG8_BAR; }
    }
    PG8_WAIT_V(0);
    if constexpr (!ALIGN_EPI) { if (wr == 0) PG8_BAR; }
    PG8_BAR;
    if constexpr (Epi::AFTER_DRAIN) { E.fused(acc, cur, wr, wc, fr, fq, lds, wid, lane); S.done(cur); }
#undef PG8_SA
#undef PG8_SB
#undef PG8_STAGE
#undef PG8_LDA
#undef PG8_LDB
#undef PG8_MMA
#undef PG8_WAIT_V
#undef PG8_WAIT_L
#undef PG8_BAR
#undef PG8_SCHED
}
}
namespace attn_body {
using bf16=__hip_bfloat16;
using bf16x8=__attribute__((ext_vector_type(8)))short;
using s16x4=__attribute__((ext_vector_type(4)))short;
using f32x16=__attribute__((ext_vector_type(16)))float;
using u32x4=__attribute__((ext_vector_type(4)))unsigned;
constexpr int SEQ=8192,D=64;
constexpr int NW=8,QBLK=32,QB=QBLK*NW,KVBLK=64,NQB=SEQ/QB;
__device__ __forceinline__ int crow(int r,int hi){return (r&3)+8*(r>>2)+4*hi;}
#define SBAR() __builtin_amdgcn_sched_barrier(0)
__device__ __forceinline__ void cmask(f32x16&p0,f32x16&p1,int jb,int qrel,int hi){
  const float NEG=-INFINITY; int kb=64*jb+4*hi;
  const int lim=qrel-kb;
  #pragma unroll
  for(int r=0;r<16;++r){const int c=(r&3)+8*(r>>2); if(c>lim)p0[r]=NEG; if(c+32>lim)p1[r]=NEG;}
}

template<int MODE,bool FULLSEL=true> __device__ __forceinline__ void tmask(f32x16&p0,f32x16&p1,int t,int NT,int qrel,int hi,const u32x4&sel){
  const float NEG=-INFINITY; const int jb=t-(NT-4);
  if(jb>=0)cmask(p0,p1,jb,qrel,hi);
  if(MODE==1){ if(jb<-4){ const int lim=qrel-(64*jb+4*hi+511);
    #pragma unroll
    for(int r=0;r<16;++r){const int c=(r&3)+8*(r>>2); if(c<lim)p0[r]=NEG; if(c+32<lim)p1[r]=NEG;} } }
  if(MODE==2&&FULLSEL){ const unsigned w=(t<32)?sel[0]:(t<64)?sel[1]:(t<96)?sel[2]:sel[3]; const bool on=((w>>(t&31))&1u)!=0u;
    if(!on){
    #pragma unroll
    for(int r=0;r<16;++r){p0[r]=NEG;p1[r]=NEG;} } }
}
struct AArgs { const bf16*Q; const bf16*K; const bf16*V; bf16*O; int qp,kp,vp,op; const float*cosT; const float*sinT; const u32x4*sel; const bf16*ocmp; const bf16*owin; const float*ga; const float*subln; bf16*ob; const float*lamp; };
__device__ __forceinline__ float bf2f(short s){return __uint_as_float(((unsigned)(unsigned short)s)<<16);}
constexpr int NSLOT=3, SLOTB=8192;
constexpr int LDS_K=0, LDS_V=NSLOT*SLOTB, LDS_WS=2*NSLOT*SLOTB, LDS_OST=LDS_WS+NW*64*4, LDS_BYTES=LDS_OST+NW*4096;
constexpr float C2=0.125f*1.4426950408889634f;
__device__ __forceinline__ void glds16(const void*gsrc,unsigned lds_dst){unsigned keep;
  asm volatile("s_mov_b32 %0, m0\n\ts_mov_b32 m0, %2\n\ts_nop 0\n\tglobal_load_lds_dwordx4 %1, off\n\ts_mov_b32 m0, %0":"=&s"(keep):"v"(gsrc),"s"(lds_dst):"memory");}
__device__ __forceinline__ float max3f(float a,float b,float c){float r;asm("v_max3_f32 %0, %1, %2, %3":"=v"(r):"v"(a),"v"(b),"v"(c));return r;}
__device__ __forceinline__ float max2f(float a,float b){float r;asm("v_max_f32_e32 %0, %1, %2":"=v"(r):"v"(a),"v"(b));return r;}
__device__ __forceinline__ float fadd_s(float a,float b){float r;asm("v_add_f32_e32 %0, %1, %2":"=v"(r):"v"(a),"v"(b));return r;}
__device__ __forceinline__ float fsub_s(float a,float b){float r;asm("v_sub_f32_e32 %0, %1, %2":"=v"(r):"v"(a),"v"(b));return r;}
typedef float f32x2_t __attribute__((ext_vector_type(2))); typedef float f32x4_t __attribute__((ext_vector_type(4))); typedef __bf16 bf16x2_t __attribute__((ext_vector_type(2)));
__device__ __forceinline__ unsigned cvtpk_s(float lo,float hi){f32x2_t v={lo,hi};bf16x2_t b=__builtin_convertvector(v,bf16x2_t);return __builtin_bit_cast(unsigned,b);}
#define WAIT_BAR(N) asm volatile("s_waitcnt vmcnt(" #N ") lgkmcnt(0)\n\ts_barrier":::"memory")

__device__ __forceinline__ void qkt(f32x16&p0,f32x16&p1,const char*Kslot,const bf16x8*qr,const f32x16&negm,int r32,int hi){
  const char*kb=Kslot+hi*1024+r32*16;
  #pragma unroll
  for(int d0=0;d0<4;++d0){
    const bf16x8 b0=*reinterpret_cast<const bf16x8*>(kb+d0*2048);
    const bf16x8 b1=*reinterpret_cast<const bf16x8*>(kb+d0*2048+512);
    if(d0==0){p0=__builtin_amdgcn_mfma_f32_32x32x16_bf16(b0,qr[0],negm,0,0,0);p1=__builtin_amdgcn_mfma_f32_32x32x16_bf16(b1,qr[0],negm,0,0,0);}
    else{p0=__builtin_amdgcn_mfma_f32_32x32x16_bf16(b0,qr[d0],p0,0,0,0);p1=__builtin_amdgcn_mfma_f32_32x32x16_bf16(b1,qr[d0],p1,0,0,0);}}
}
typedef __attribute__((address_space(3))) const char* lds_cptr;
typedef short v4i16_t __attribute__((ext_vector_type(4)));
__device__ __forceinline__ void kload8(bf16x8*kf,lds_cptr kp){
  kf[0]=*(const __attribute__((address_space(3))) bf16x8*)(kp);      kf[1]=*(const __attribute__((address_space(3))) bf16x8*)(kp+512);
  kf[2]=*(const __attribute__((address_space(3))) bf16x8*)(kp+2048); kf[3]=*(const __attribute__((address_space(3))) bf16x8*)(kp+2560);
  kf[4]=*(const __attribute__((address_space(3))) bf16x8*)(kp+4096); kf[5]=*(const __attribute__((address_space(3))) bf16x8*)(kp+4608);
  kf[6]=*(const __attribute__((address_space(3))) bf16x8*)(kp+6144); kf[7]=*(const __attribute__((address_space(3))) bf16x8*)(kp+6656);
}
__device__ __forceinline__ void kload2(bf16x8*kf,lds_cptr kp,int j){ kf[2*j]=*(const __attribute__((address_space(3))) bf16x8*)(kp+j*2048); kf[2*j+1]=*(const __attribute__((address_space(3))) bf16x8*)(kp+j*2048+512); }
__device__ __forceinline__ s16x4 vtr(lds_cptr p){ return __builtin_bit_cast(s16x4,__builtin_amdgcn_ds_read_tr16_b64_v4i16((__attribute__((address_space(3))) v4i16_t*)p)); }
__device__ __forceinline__ float rowmax(const f32x16&p0,const f32x16&p1){
  float a=max3f(p0[0],p0[1],p1[0]),b=max3f(p0[2],p0[3],p1[1]);a=max3f(a,p1[2],p1[3]);
  #pragma unroll
  for(int r=4;r<16;r+=4){a=max3f(a,p0[r],p0[r+1]);b=max3f(b,p0[r+2],p0[r+3]);a=max3f(a,p1[r],p1[r+1]);b=max3f(b,p1[r+2],p1[r+3]);}
  const float m=max2f(a,b);
  auto rr=__builtin_amdgcn_permlane32_swap(__float_as_uint(m),__float_as_uint(m),false,false);
  return max2f(__uint_as_float(rr[0]),__uint_as_float(rr[1]));
}
__device__ __forceinline__ void pv(f32x16*o,int vb,bf16x8 pa0,bf16x8 pa1,bf16x8 pa2,bf16x8 pa3){
  #pragma unroll
  for(int d0=0;d0<2;++d0){s16x4 lo[4],hi[4];
    #pragma unroll
    for(int ks=0;ks<4;++ks){
      asm volatile("ds_read_b64_tr_b16 %0,%1 offset:%c2":"=&v"(lo[ks]):"v"(vb),"i"(d0*4096+ks*1024):"memory");
      asm volatile("ds_read_b64_tr_b16 %0,%1 offset:%c2":"=&v"(hi[ks]):"v"(vb),"i"(d0*4096+ks*1024+512):"memory");}
    asm volatile("s_waitcnt lgkmcnt(0)":::"memory");SBAR();
    #define PK(k) (bf16x8){lo[k][0],lo[k][1],lo[k][2],lo[k][3],hi[k][0],hi[k][1],hi[k][2],hi[k][3]}
    o[d0]=__builtin_amdgcn_mfma_f32_32x32x16_bf16(pa0,PK(0),o[d0],0,0,0);
    o[d0]=__builtin_amdgcn_mfma_f32_32x32x16_bf16(pa1,PK(1),o[d0],0,0,0);
    o[d0]=__builtin_amdgcn_mfma_f32_32x32x16_bf16(pa2,PK(2),o[d0],0,0,0);
    o[d0]=__builtin_amdgcn_mfma_f32_32x32x16_bf16(pa3,PK(3),o[d0],0,0,0);
    #undef PK
  }
}

#ifndef ATTN_STORE16
#define ATTN_STORE16(p,v) (*(u32x4*)(p)=(v))
#endif
#ifndef ATTN_QLDS
#define ATTN_QLDS 0
#endif
#ifndef ATTN_NEGM_MASK
#define ATTN_NEGM_MASK 0x2
#endif
template<int MODE,int THRL> __device__ __forceinline__ void attn_unit(int b,int qc,int kc,int vc,int oc,int hq,int grp,int qb,const AArgs&A_,char*shm,const bool epi_=false){
  const bool EPI=(MODE==3)&&epi_;
  AArgs A=A_;
  asm volatile("":"+s"(A.Q),"+s"(A.K),"+s"(A.V),"+s"(A.O)); asm volatile("":"+s"(A.cosT),"+s"(A.sinT),"+s"(A.sel)); asm volatile("":"+s"(A.ocmp),"+s"(A.owin),"+s"(A.ga)); asm volatile("":"+s"(A.subln),"+s"(A.ob),"+s"(A.lamp));
  int tid_=threadIdx.x; asm volatile("":"+v"(tid_)); const int tid=tid_,lane=tid&63,r32=lane&31,hi=lane>>5; const int wid=__builtin_amdgcn_readfirstlane(tid>>6);
  const long rowbase=(long)b*SEQ; const int q0=qb*QB; constexpr int qp=512,kp=(MODE==0||MODE==3)?512:128,vp=kp,op=(MODE==0||MODE==3)?1024:512;
  constexpr int NDB=(MODE==3)?4:2,VMUL=NDB/2;
  constexpr int L_WS=LDS_V+NSLOT*SLOTB*VMUL,L_OST=L_WS+NW*64*4,OSTW=(MODE==3)?8192:4096;
  const int ts=(MODE==1)?((4*qb-8)>0?(4*qb-8):0):0;
  const bf16*Qw=A.Q+(rowbase+q0+wid*QBLK)*qp+qc;
  const bf16*Kh=A.K+(rowbase+(long)ts*KVBLK)*kp+kc,*Vh=A.V+(rowbase+(long)ts*KVBLK)*vp+vc;
  const unsigned lds0=(unsigned)(uintptr_t)shm;
  float*wsf=(float*)(shm+L_WS)+wid*64;
  const bf16*ksrc=Kh+(long)lane*kp+wid*8;
  const bf16*vsrc=Vh+(long)(16*(wid&3)+(lane>>2))*vp+(wid>>2)*32+(lane&3)*8;
  const unsigned kdst=lds0+LDS_K+wid*1024, vdst=lds0+LDS_V+wid*1024;
  #define DMA_K(t,slot) glds16(ksrc+(long)(t)*KVBLK*kp,(unsigned)__builtin_amdgcn_readfirstlane(kdst+(slot)))
  #define DMA_V(t,slot) do{ glds16(vsrc+(long)(t)*KVBLK*vp,(unsigned)__builtin_amdgcn_readfirstlane(vdst+(slot)*VMUL)); if(MODE==3) glds16(vsrc+64+(long)(t)*KVBLK*vp,(unsigned)__builtin_amdgcn_readfirstlane(vdst+(slot)*VMUL+8192)); }while(0)
  #define WB3() do{ if(MODE==3){WAIT_BAR(4);} else {WAIT_BAR(3);} }while(0)
  #define WB2() do{ if(MODE==3){WAIT_BAR(3);} else {WAIT_BAR(2);} }while(0)
  #define WB1() do{ if(MODE==3){WAIT_BAR(2);} else {WAIT_BAR(1);} }while(0)
  const int vb0=(int)(lds0+LDS_V)+((lane>>4)&1)*32+(lane&3)*8+(4*hi+((lane&15)>>2))*64;
  const char*Kbase=shm+LDS_K; bf16x8 kf[8];
  const lds_cptr shm3=(lds_cptr)shm; const lds_cptr kp0=shm3+LDS_K+hi*1024+r32*16; const lds_cptr vp0=shm3+LDS_V+((lane>>4)&1)*32+(lane&3)*8+(4*hi+((lane&15)>>2))*64;
  const int NT=(q0+QB)/KVBLK-ts;
  DMA_K(0,0);DMA_V(0,0);DMA_K(1,SLOTB);
  bf16x8 qr[4];
  #pragma unroll
  for(int d0=0;d0<4;++d0)qr[d0]=*reinterpret_cast<const bf16x8*>(&Qw[(long)r32*qp+d0*16+hi*8]);
  u32x4 sel=(u32x4){0u,0u,0u,0u};
  if(MODE==1||MODE==2){
    const long qrow=rowbase+q0+wid*QBLK+r32;
    #pragma unroll
    for(int d0=0;d0<4;++d0){ const int g8=2*d0+hi; const f32x4_t c=*reinterpret_cast<const f32x4_t*>(A.cosT+qrow*32+4*g8), s=*reinterpret_cast<const f32x4_t*>(A.sinT+qrow*32+4*g8);
      u32x4 w;
      #pragma unroll
      for(int j=0;j<4;++j){ const float x1=bf2f(qr[d0][j]),x2=bf2f(qr[d0][j+4]); const float y1=x1*c[j]-x2*s[j], y2=x2*c[j]+x1*s[j]; qr[d0][j]=(short)(cvtpk_s(y1,0.f)&0xffffu); qr[d0][j+4]=(short)(cvtpk_s(y2,0.f)&0xffffu); }
    }
    if(MODE==2) sel=A.sel[qrow*2+grp];
  }
  typedef __attribute__((address_space(3))) bf16x8 lds_bf16x8;
  lds_bf16x8*qst=(lds_bf16x8*)(shm3+L_OST+wid*OSTW)+lane;
  constexpr bool QLDS=(MODE==3)&&(ATTN_QLDS!=0);
  if(QLDS){
    #pragma unroll
    for(int d0=0;d0<4;++d0)qst[d0*64]=qr[d0];
    asm volatile("s_waitcnt lgkmcnt(0)":::"memory"); }
  #define QR(d) (QLDS?(bf16x8)qst[(d)*64]:qr[d])
  float mhat=0.f,l_reg=0.f;f32x16 o[NDB];
  #pragma unroll
  for(int d_=0;d_<NDB;++d_)o[d_]=f32x16{};
  constexpr bool NEGM=((ATTN_NEGM_MASK>>MODE)&1)!=0; f32x16 negm=f32x16{}; if(NEGM) asm volatile("":"+v"(negm));
  const int qrel=wid*QBLK+r32;
  #define CMASK(P0,P1,t) tmask<MODE>(P0,P1,(t),NT,qrel,hi,sel)
  bool resc=false;
  #define START(P0,P1) do{ const float rm=rowmax(P0,P1); resc=false; \
    { const float dl=__builtin_fmaxf(rm,-1000.f); mhat=fadd_s(mhat,dl); \
      _Pragma("unroll") for(int r=0;r<16;++r){P0[r]=fsub_s(P0[r],dl);P1[r]=fsub_s(P1[r],dl);} \
      if(NEGM){ _Pragma("unroll") for(int r=0;r<16;++r)negm[r]=-mhat; asm volatile("":"+v"(negm)); } } \
    _Pragma("unroll") for(int r=0;r<16;++r)P0[r]=__builtin_amdgcn_exp2f(P0[r]); }while(0)
  #define RESC() do{ if(resc){ asm volatile("s_waitcnt lgkmcnt(0)":::"memory"); \
      _Pragma("unroll") for(int d_=0;d_<NDB;++d_) _Pragma("unroll") for(int r=0;r<16;++r)o[d_][r]*=wsf[crow(r,hi)]; } }while(0)
  f32x16 pA0,pA1,pB0,pB1;
  int sl_prev=0,sl_cur=0,sl_next=SLOTB;
  #define ROT() do{sl_prev=sl_cur;sl_cur=sl_next;sl_next=(sl_next==(NSLOT-1)*SLOTB)?0:sl_next+SLOTB;}while(0)
  DMA_K(2,2*SLOTB);
  WB3();
  { bf16x8 q4_[4]; _Pragma("unroll") for(int d_=0;d_<4;++d_)q4_[d_]=QR(d_); qkt(pA0,pA1,Kbase,q4_,negm,r32,hi); }asm volatile("s_nop 15\n\ts_nop 7":"+v"(pA0),"+v"(pA1));CMASK(pA0,pA1,0);
  START(pA0,pA1);
  _Pragma("unroll") for(int r=0;r<16;++r)pA1[r]=__builtin_amdgcn_exp2f(pA1[r]);
  WAIT_BAR(0);
  DMA_K(3,0);DMA_V(1,SLOTB);
  ROT();
  kload8(kf,kp0+sl_cur);
  WB2();
  s16x4 vlo[8],vhi[8]; u32x4 pw0,pw1,pw2,pw3;
  #define PKW(P,B) cvtpk_s(P[B],P[B+1])
  #define PAF(k) __builtin_bit_cast(bf16x8,pw##k)
  #define VFR(i) (bf16x8){vlo[i][0],vlo[i][1],vlo[i][2],vlo[i][3],vhi[i][0],vhi[i][1],vhi[i][2],vhi[i][3]}
  #define PIN(x) asm volatile("":"+v"(x))
  #define MX3(a,b,c) __builtin_fmaxf(__builtin_fmaxf((a),(b)),(c))
  #define GAPA(MF,A0,A1,A2,A3,W0,W1,PW) do{ MF; sacc+=A0; sacc+=A1; sacc+=A2; sacc+=A3; PIN(sacc); W0; W1; PIN(PW); SBAR(); }while(0)
  #define EX(v) (NEGM?__builtin_amdgcn_exp2f(v):__builtin_amdgcn_exp2f((v)-msub_))
  #define EX2(X,B) do{ if(NEGM){ X[B]=__builtin_amdgcn_exp2f(X[B]); X[B+1]=__builtin_amdgcn_exp2f(X[B+1]); } else { const f32x2_t d_=(f32x2_t){X[B],X[B+1]}-(f32x2_t){msub_,msub_}; X[B]=__builtin_amdgcn_exp2f(d_.x); X[B+1]=__builtin_amdgcn_exp2f(d_.y); } }while(0)
  #define GAPB(MF,X,B) do{ MF; EX2(X,B); EX2(X,B+2); PIN(X); SBAR(); }while(0)
  #define GAPB2(MF,X,B) do{ MF; EX2(X,B); PIN(X); SBAR(); }while(0)
  #define VRD2(i) do{ vlo[i]=vtr(vq_+(((i)>>2)*4096+((i)&3)*1024)); vhi[i]=vtr(vq_+(((i)>>2)*4096+((i)&3)*1024+512)); }while(0)
  #define VRD(i) do{ vlo[i]=vtr(vp_+(((i)>>2)*4096+((i)&3)*1024)); vhi[i]=vtr(vp_+(((i)>>2)*4096+((i)&3)*1024+512)); }while(0)
  #define KRD(G,j) do{ if(G){ kload2(kf,kp0+sl_next,j); SBAR(); } }while(0)
  #define STEP(C0,C1,P0,P1,t,GK,GV,GL) do{ SBAR(); \
    const lds_cptr vp_=vp0+sl_prev*VMUL; \
    bf16x8 qa_=qn0,qb_; VRD(0); SBAR(); float sacc=(P0[0]+P0[1]); \
    GAPA(C0=__builtin_amdgcn_mfma_f32_32x32x16_bf16(kf[0],qa_,negm,0,0,0), P0[2],P0[3],P0[4],P0[5],     pw0[0]=PKW(P0,0), pw0[1]=PKW(P0,2), pw0); \
    VRD(4); qb_=QR(1); SBAR(); GAPA(C1=__builtin_amdgcn_mfma_f32_32x32x16_bf16(kf[1],qa_,negm,0,0,0), P0[6],P0[7],P0[8],P0[9],     pw0[2]=PKW(P0,4), pw0[3]=PKW(P0,6), pw0); \
    VRD(1); SBAR(); GAPA(C0=__builtin_amdgcn_mfma_f32_32x32x16_bf16(kf[2],qb_,C0,0,0,0),   P0[10],P0[11],P0[12],P0[13], pw1[0]=PKW(P0,8), pw1[1]=PKW(P0,10), pw1); \
    VRD(5); qa_=QR(2); SBAR(); GAPA(C1=__builtin_amdgcn_mfma_f32_32x32x16_bf16(kf[3],qb_,C1,0,0,0),   P0[14],P0[15],P1[0],P1[1],   pw1[2]=PKW(P0,12),pw1[3]=PKW(P0,14), pw1); \
    VRD(2); SBAR(); GAPA(C0=__builtin_amdgcn_mfma_f32_32x32x16_bf16(kf[4],qa_,C0,0,0,0),   P1[2],P1[3],P1[4],P1[5],     pw2[0]=PKW(P1,0), pw2[1]=PKW(P1,2), pw2); \
    VRD(6); qb_=QR(3); SBAR(); GAPA(C1=__builtin_amdgcn_mfma_f32_32x32x16_bf16(kf[5],qa_,C1,0,0,0),   P1[6],P1[7],P1[8],P1[9],     pw2[2]=PKW(P1,4), pw2[3]=PKW(P1,6), pw2); \
    VRD(3); SBAR(); GAPA(C0=__builtin_amdgcn_mfma_f32_32x32x16_bf16(kf[6],qb_,C0,0,0,0),   P1[10],P1[11],P1[12],P1[13], pw3[0]=PKW(P1,8), pw3[1]=PKW(P1,10), pw3); \
    VRD(7); SBAR(); GAPA(C1=__builtin_amdgcn_mfma_f32_32x32x16_bf16(kf[7],qb_,C1,0,0,0),   P1[14],P1[15],0.f,0.f,       pw3[2]=PKW(P1,12),pw3[3]=PKW(P1,14), pw3); \
    l_reg+=sacc; qn0=QR(0); \
    if(GK){DMA_K((t)+3,sl_cur);} if(GV){DMA_V((t)+1,sl_next);} \
    bool on_=true; if(!NEGM&&MODE==2){ const int tt_=(t); const unsigned w_=(tt_<32)?sel[0]:(tt_<64)?sel[1]:(tt_<96)?sel[2]:sel[3]; on_=((w_>>(tt_&31))&1u)!=0u; } \
    CMASK(C0,C1,t); \
    { float a=MX3(C0[0],C0[1],C1[0]),b=MX3(C0[2],C0[3],C1[1]); a=MX3(a,C1[2],C1[3]); \
      _Pragma("unroll") for(int r=4;r<16;r+=4){a=MX3(a,C0[r],C0[r+1]);b=MX3(b,C0[r+2],C0[r+3]);a=MX3(a,C1[r],C1[r+1]);b=MX3(b,C1[r+2],C1[r+3]);} \
      float rm=__builtin_fmaxf(a,b); { auto rr=__builtin_amdgcn_permlane32_swap(__float_as_uint(rm),__float_as_uint(rm),false,false); rm=__builtin_fmaxf(__uint_as_float(rr[0]),__uint_as_float(rr[1])); } \
      if(!NEGM) rm-=mhat;     \
      resc=false; \
      if(__builtin_expect(__any(rm>(float)THRL),0)){ const float dl=__builtin_fmaxf(rm,0.f); mhat+=dl; \
        if(NEGM){ _Pragma("unroll") for(int r=0;r<16;++r){C0[r]-=dl;C1[r]-=dl;} } \
        if(NEGM){ _Pragma("unroll") for(int r=0;r<16;++r)negm[r]=-mhat; asm volatile("":"+v"(negm)); } \
        const float f=__builtin_amdgcn_exp2f(-dl); l_reg*=f; if(hi==0)wsf[r32]=f; resc=true; } } \
    const float msub_=on_?mhat:INFINITY;     \
    SBAR(); \
    if(MODE==3){ const lds_cptr vq_=vp_+8192;     \
      GAPB2(o[0]=__builtin_amdgcn_mfma_f32_32x32x16_bf16(PAF(0),VFR(0),o[0],0,0,0), C0,0); VRD2(0); SBAR(); \
      GAPB2(o[1]=__builtin_amdgcn_mfma_f32_32x32x16_bf16(PAF(0),VFR(4),o[1],0,0,0), C0,2); VRD2(4); SBAR(); \
      KRD(GL,0); GAPB2(o[0]=__builtin_amdgcn_mfma_f32_32x32x16_bf16(PAF(1),VFR(1),o[0],0,0,0), C0,4); VRD2(1); SBAR(); \
      KRD(GL,1); GAPB2(o[1]=__builtin_amdgcn_mfma_f32_32x32x16_bf16(PAF(1),VFR(5),o[1],0,0,0), C0,6); VRD2(5); SBAR(); \
      KRD(GL,2); GAPB2(o[0]=__builtin_amdgcn_mfma_f32_32x32x16_bf16(PAF(2),VFR(2),o[0],0,0,0), C0,8); VRD2(2); SBAR(); \
      KRD(GL,3); GAPB2(o[1]=__builtin_amdgcn_mfma_f32_32x32x16_bf16(PAF(2),VFR(6),o[1],0,0,0), C0,10); VRD2(6); SBAR(); \
      GAPB2(o[0]=__builtin_amdgcn_mfma_f32_32x32x16_bf16(PAF(3),VFR(3),o[0],0,0,0), C0,12); VRD2(3); SBAR(); \
      GAPB2(o[1]=__builtin_amdgcn_mfma_f32_32x32x16_bf16(PAF(3),VFR(7),o[1],0,0,0), C0,14); VRD2(7); SBAR(); \
      GAPB2(o[2]=__builtin_amdgcn_mfma_f32_32x32x16_bf16(PAF(0),VFR(0),o[2],0,0,0), C1,0); \
      GAPB2(o[3]=__builtin_amdgcn_mfma_f32_32x32x16_bf16(PAF(0),VFR(4),o[3],0,0,0), C1,2); \
      GAPB2(o[2]=__builtin_amdgcn_mfma_f32_32x32x16_bf16(PAF(1),VFR(1),o[2],0,0,0), C1,4); \
      GAPB2(o[3]=__builtin_amdgcn_mfma_f32_32x32x16_bf16(PAF(1),VFR(5),o[3],0,0,0), C1,6); \
      GAPB2(o[2]=__builtin_amdgcn_mfma_f32_32x32x16_bf16(PAF(2),VFR(2),o[2],0,0,0), C1,8); \
      GAPB2(o[3]=__builtin_amdgcn_mfma_f32_32x32x16_bf16(PAF(2),VFR(6),o[3],0,0,0), C1,10); \
      GAPB2(o[2]=__builtin_amdgcn_mfma_f32_32x32x16_bf16(PAF(3),VFR(3),o[2],0,0,0), C1,12); \
      GAPB2(o[3]=__builtin_amdgcn_mfma_f32_32x32x16_bf16(PAF(3),VFR(7),o[3],0,0,0), C1,14); \
    } else { \
    GAPB(o[0]=__builtin_amdgcn_mfma_f32_32x32x16_bf16(PAF(0),VFR(0),o[0],0,0,0), C0,0); \
    GAPB(o[1]=__builtin_amdgcn_mfma_f32_32x32x16_bf16(PAF(0),VFR(4),o[1],0,0,0), C0,4); \
    KRD(GL,0); GAPB(o[0]=__builtin_amdgcn_mfma_f32_32x32x16_bf16(PAF(1),VFR(1),o[0],0,0,0), C0,8); \
    KRD(GL,1); GAPB(o[1]=__builtin_amdgcn_mfma_f32_32x32x16_bf16(PAF(1),VFR(5),o[1],0,0,0), C0,12); \
    KRD(GL,2); GAPB(o[0]=__builtin_amdgcn_mfma_f32_32x32x16_bf16(PAF(2),VFR(2),o[0],0,0,0), C1,0); \
    KRD(GL,3); GAPB(o[1]=__builtin_amdgcn_mfma_f32_32x32x16_bf16(PAF(2),VFR(6),o[1],0,0,0), C1,4); \
    GAPB(o[0]=__builtin_amdgcn_mfma_f32_32x32x16_bf16(PAF(3),VFR(3),o[0],0,0,0), C1,8); \
    GAPB(o[1]=__builtin_amdgcn_mfma_f32_32x32x16_bf16(PAF(3),VFR(7),o[1],0,0,0), C1,12); \
    } \
    }while(0)
  int t=1; bf16x8 qn0=QR(0);
  #undef CMASK
  #define CMASK(P0,P1,t) do{ if(MODE==1) tmask<MODE>(P0,P1,(t),NT,qrel,hi,sel); }while(0)
  for(;t+5<NT;t+=2){
    STEP(pB0,pB1,pA0,pA1,t,true,true,true);     WB2(); RESC(); ROT();
    STEP(pA0,pA1,pB0,pB1,t+1,true,true,true);   WB2(); RESC(); ROT();
  }
  #undef CMASK
  #define CMASK(P0,P1,t) tmask<MODE,false>(P0,P1,(t),NT,qrel,hi,sel)
  #define ENDW(tt) do{ if((tt)+3<NT){WB2();} else if((tt)+2<NT){WB1();} else {WAIT_BAR(0);} }while(0)
  for(;t+1<NT;t+=2){
    STEP(pB0,pB1,pA0,pA1,t,(t+3<NT),(t+1<NT),(t+1<NT));       ENDW(t);   RESC(); ROT();
    STEP(pA0,pA1,pB0,pB1,t+1,(t+4<NT),(t+2<NT),(t+2<NT));     ENDW(t+1); RESC(); ROT();
  }
  STEP(pB0,pB1,pA0,pA1,NT-1,false,false,false); RESC();
  { float sacc=pB0[0]+pB0[1]; _Pragma("unroll") for(int r=2;r<16;++r)sacc+=pB0[r]; _Pragma("unroll") for(int r=0;r<16;++r)sacc+=pB1[r]; l_reg+=sacc;
    pw0=(u32x4){PKW(pB0,0),PKW(pB0,2),PKW(pB0,4),PKW(pB0,6)};pw1=(u32x4){PKW(pB0,8),PKW(pB0,10),PKW(pB0,12),PKW(pB0,14)};pw2=(u32x4){PKW(pB1,0),PKW(pB1,2),PKW(pB1,4),PKW(pB1,6)};pw3=(u32x4){PKW(pB1,8),PKW(pB1,10),PKW(pB1,12),PKW(pB1,14)};
    SBAR(); pv(o,vb0+sl_cur*VMUL,PAF(0),PAF(1),PAF(2),PAF(3)); if(MODE==3) pv(o+(NDB-2),vb0+sl_cur*VMUL+8192,PAF(0),PAF(1),PAF(2),PAF(3)); }
  #undef PKW
  #undef PAF
  #undef VFR
  #undef PIN
  #undef MX3
  #undef GAPA
  #undef GAPB
  #undef EX
  #undef VRD
  #undef VRD2
  #undef GAPB2
  #undef EX2
  #undef KRD
  #undef STEP
  #undef ENDW
  {auto rr=__builtin_amdgcn_permlane32_swap(__float_as_uint(l_reg),__float_as_uint(l_reg),false,false);l_reg=__uint_as_float(rr[0])+__uint_as_float(rr[1]);}
  if(hi==0)wsf[32+r32]=l_reg;asm volatile("s_waitcnt lgkmcnt(0)":::"memory");
  float rli[16];
  #pragma unroll
  for(int r=0;r<16;++r)rli[r]=__builtin_amdgcn_rcpf(wsf[32+crow(r,hi)]);
  bf16*Ow=A.O+(rowbase+q0+wid*QBLK)*op+oc;
  u32x4 c8_[4],w8_[4]; float gg_[4][3];
  if(MODE==2){
    #pragma unroll
    for(int i=0;i<4;++i){ const int row=i*8+(lane>>3),ch=lane&7; const long grow=rowbase+q0+wid*QBLK+row;
      c8_[i]=*(const u32x4*)(A.ocmp+grow*512+hq*64+ch*8); w8_[i]=*(const u32x4*)(A.owin+grow*512+hq*64+ch*8);
      gg_[i][0]=A.ga[grow*24+hq*3+0]; gg_[i][1]=A.ga[grow*24+hq*3+1]; gg_[i][2]=A.ga[grow*24+hq*3+2]; } }
  if(!EPI)
  #pragma unroll
  for(int h2=0;h2<NDB/2;++h2){ bf16*stg=(bf16*)(shm+L_OST)+wid*(OSTW/2);
    #pragma unroll
    for(int r=0;r<16;++r){const int orow=crow(r,hi);
      #pragma unroll
      for(int d0=0;d0<2;++d0)stg[orow*64+d0*32+r32]=__float2bfloat16(o[2*h2+d0][r]*rli[r]);}
    asm volatile("s_waitcnt lgkmcnt(0)":::"memory");
    #pragma unroll
    for(int i=0;i<4;++i){const int row=i*8+(lane>>3),ch=lane&7; u32x4 v=*(const u32x4*)(stg+row*64+ch*8);
      if(MODE==2){ const u32x4 c8=c8_[i], w8=w8_[i]; const float g0=gg_[i][0],g1=gg_[i][1],g2=gg_[i][2];
        #pragma unroll
        for(int k=0;k<4;++k){ const float lo=g0*__uint_as_float(c8[k]<<16)+g1*__uint_as_float(v[k]<<16)+g2*__uint_as_float(w8[k]<<16);
          const float hi2=g0*__uint_as_float(c8[k]&0xffff0000u)+g1*__uint_as_float(v[k]&0xffff0000u)+g2*__uint_as_float(w8[k]&0xffff0000u); v[k]=cvtpk_s(lo,hi2); } }
      ATTN_STORE16(Ow+(long)row*op+h2*64+ch*8,v);}
    asm volatile("s_waitcnt lgkmcnt(0)":::"memory"); }
  if(EPI){ const int hd=oc>>8;
    bf16*stg=(bf16*)(shm+L_OST)+wid*(OSTW/2);
    const float lam_=A.lamp[0],post_=A.lamp[1];
    #pragma unroll
    for(int r=0;r<16;++r){const int orow=crow(r,hi);
      #pragma unroll
      for(int d0=0;d0<NDB;++d0)stg[orow*128+d0*32+r32]=__float2bfloat16(o[d0][r]*rli[r]);}
    asm volatile("s_waitcnt lgkmcnt(0)":::"memory");
    #pragma unroll
    for(int i=0;i<4;++i){ const int row=i*8+(lane>>3),ch=lane&7; const long grow=rowbase+q0+wid*QBLK+row; float av[2][8]; float ss=0.f;
      #pragma unroll
      for(int h2=0;h2<2;++h2){ const u32x4 v=*(const u32x4*)(stg+row*128+h2*64+ch*8); const u32x4 o1=*(const u32x4*)(Ow+(long)row*op-128+h2*64+ch*8);
        #pragma unroll
        for(int k=0;k<4;++k){ const float lo=__uint_as_float(o1[k]<<16)-lam_*__uint_as_float(v[k]<<16), hi2=__uint_as_float(o1[k]&0xffff0000u)-lam_*__uint_as_float(v[k]&0xffff0000u);
          av[h2][2*k]=lo; av[h2][2*k+1]=hi2; ss+=lo*lo+hi2*hi2; } }
      ss+=__shfl_xor(ss,1); ss+=__shfl_xor(ss,2); ss+=__shfl_xor(ss,4);
      const float rs=post_*__builtin_amdgcn_rsqf(ss*(1.0f/128.0f)+1e-6f);
      #pragma unroll
      for(int h2=0;h2<2;++h2){ const f32x4_t g0=*reinterpret_cast<const f32x4_t*>(A.subln+h2*64+ch*8), g1=*reinterpret_cast<const f32x4_t*>(A.subln+h2*64+ch*8+4);
        u32x4 w; w[0]=cvtpk_s(av[h2][0]*rs*g0[0],av[h2][1]*rs*g0[1]); w[1]=cvtpk_s(av[h2][2]*rs*g0[2],av[h2][3]*rs*g0[3]); w[2]=cvtpk_s(av[h2][4]*rs*g1[0],av[h2][5]*rs*g1[1]); w[3]=cvtpk_s(av[h2][6]*rs*g1[2],av[h2][7]*rs*g1[3]);
        *(u32x4*)(A.ob+grow*512+hd*128+h2*64+ch*8)=w; } } }
  asm volatile("s_waitcnt lgkmcnt(0)\n\ts_barrier":::"memory");
  #undef DMA_K
  #undef DMA_V
  #undef QR
  #undef WB3
  #undef WB2
  #undef WB1
  #undef CMASK
  #undef START
  #undef RESC
  #undef ROT
}
constexpr int ATTN_LDS_BYTES=LDS_BYTES;
#undef SBAR
#undef WAIT_BAR
}

#define LAS __attribute__((address_space(3)))
typedef unsigned short bf16_t;
typedef short bf16x8 __attribute__((ext_vector_type(8)));
typedef float f32x4 __attribute__((ext_vector_type(4)));
typedef unsigned u32x4 __attribute__((ext_vector_type(4)));
typedef unsigned u32x2 __attribute__((ext_vector_type(2)));
constexpr int NB = 4, SEQ = 8192, DMODEL = 1024, MTOK = NB * SEQ, NCAT = 7168, DFF = 2816, NFF13 = 2 * DFF, DIN = 3864;
constexpr float C2 = 0.125f * 1.4426950408889634f, EPS = 1e-6f;
constexpr size_t KiB = 1024, MiB = 1u << 20;
constexpr size_t WS_BIAS1 = 0, WS_KC = 64 * KiB, WS_VCT = 576 * KiB, WS_WC2 = 1536 * KiB;
constexpr size_t WS_COS = 2 * MiB, WS_SIN = 6 * MiB;
constexpr size_t WS_WCAT = 10 * MiB, WS_WBR = 24 * MiB, WS_WOUT = 27 * MiB, WS_W13 = 29 * MiB, WS_W2 = 40 * MiB, WS_WC1 = 46 * MiB;
constexpr size_t WS_H64 = 48 * MiB;
constexpr size_t WS_QA = 112 * MiB, WS_KCMP = 144 * MiB, WS_VCMP = 152 * MiB, WS_KSLC = 160 * MiB, WS_VSLC = 168 * MiB, WS_KWIN = 176 * MiB, WS_VWIN = 184 * MiB;
constexpr size_t WS_QB = 192 * MiB, WS_KB = 224 * MiB, WS_VB = 256 * MiB, WS_U = 288 * MiB, WS_V = 320 * MiB, WS_GA = 352 * MiB;
constexpr size_t WS_HID = 112 * MiB, WS_OCMP = WS_V;
constexpr size_t WS_GATES = 356 * MiB, WS_OWIN = 452 * MiB, WS_SEL = 484 * MiB, WS_END = 486 * MiB;
constexpr int LDS_BYTES = 159744, LDS_BARW = LDS_BYTES - 64;
constexpr size_t WS_LAM = 1624 * KiB;
constexpr size_t WS_BAR = 1600 * KiB, WS_BAR_BYTES = 16 * KiB;

struct KArgs { const void* in[29]; float* out; unsigned char* ws; };
typedef const void* const __attribute__((address_space(4)))* KP;
struct KIn { KP p; __device__ __forceinline__ const void* operator[](int i) const { return p[i]; } };
struct KA { KIn in; float* out; unsigned char* ws; };
__device__ __forceinline__ KA make_ka() { KP p = (KP)__builtin_amdgcn_kernarg_segment_ptr(); asm volatile("" : "+s"(p)); KA a; a.in.p = p; a.out = (float*)p[29]; a.ws = (unsigned char*)p[30]; return a; }

__device__ __forceinline__ float wave_sum(float v) {
#pragma unroll
    for (int o = 1; o < 64; o <<= 1) v += __shfl_xor(v, o);
    return v;
}
__device__ __forceinline__ unsigned pk2(float lo, float hi) { return pg8::cvt_pk_bf16(lo, hi); }
__device__ __forceinline__ float bflo(unsigned w) { return __uint_as_float(w << 16); }
__device__ __forceinline__ float bfhi(unsigned w) { return __uint_as_float(w & 0xffff0000u); }
__device__ __forceinline__ int rope_perm(int p) { const int g8 = p >> 3, j = p & 7; return (j < 4) ? 4 * g8 + j : 32 + 4 * g8 + (j - 4); }
__device__ __forceinline__ f32x4 mfma16(bf16x8 a, bf16x8 b, f32x4 c) { return __builtin_amdgcn_mfma_f32_16x16x32_bf16(a, b, c, 0, 0, 0); }
#define LDS_WAIT() asm volatile("s_waitcnt lgkmcnt(0)" ::: "memory")

template <class F> __device__ __forceinline__ void conv_items(bf16_t* dst, int K, int ndest, F colp, LAS float* scr, int gw, int NGW, int lane) {
    const int nblk = ndest / 32, items = nblk * (K / 64);
    for (int it = gw; it < items; it += NGW) {
        const int nb = it % nblk, kb = it / nblk, n0 = nb * 32, k0 = kb * 64;
        const float* cp; int ld; colp(n0 + (lane & 7) * 4, cp, ld);
#pragma unroll
        for (int i = 0; i < 8; ++i) { const int kk = 8 * i + (lane >> 3); const f32x4 v = cp ? *(const f32x4*)(cp + (size_t)(k0 + kk) * ld) : (f32x4){0.f, 0.f, 0.f, 0.f};
            LAS float* d = scr + kk * 33 + (lane & 7) * 4; d[0] = v.x; d[1] = v.y; d[2] = v.z; d[3] = v.w; }
        LDS_WAIT();
        const int c = lane & 7;
#pragma unroll
        for (int j = 0; j < 4; ++j) { const int n = (lane >> 3) + 8 * j; const LAS float* s = scr + (8 * c) * 33 + n;
            u32x4 o; o.x = pk2(s[0 * 33], s[1 * 33]); o.y = pk2(s[2 * 33], s[3 * 33]); o.z = pk2(s[4 * 33], s[5 * 33]); o.w = pk2(s[6 * 33], s[7 * 33]);
            *(u32x4*)(dst + (size_t)(n0 + n) * K + k0 + 8 * c) = o; }
        LDS_WAIT();
    }
}

__device__ __forceinline__ void rms_rows_bf16(const float* x, const float* gain, bf16_t* out, int gw, int NGW, int lane) {
    for (int m = gw; m < MTOK; m += 2 * NGW) {
        const int m2 = (m + NGW < MTOK) ? m + NGW : m;
        const f32x4* xr = (const f32x4*)(x + (size_t)m * DMODEL) + lane; const f32x4* xr2 = (const f32x4*)(x + (size_t)m2 * DMODEL) + lane; f32x4 v[4], w[4]; float s = 0.f, s2 = 0.f;
#pragma unroll
        for (int j = 0; j < 4; ++j) { v[j] = xr[64 * j]; w[j] = xr2[64 * j]; }
#pragma unroll
        for (int j = 0; j < 4; ++j) { s += (v[j].x * v[j].x + v[j].y * v[j].y) + (v[j].z * v[j].z + v[j].w * v[j].w); s2 += (w[j].x * w[j].x + w[j].y * w[j].y) + (w[j].z * w[j].z + w[j].w * w[j].w); }
        const float rs = 1.0f / sqrtf(wave_sum(s) * (1.0f / DMODEL) + EPS), rs2 = 1.0f / sqrtf(wave_sum(s2) * (1.0f / DMODEL) + EPS);
        u32x2* o = (u32x2*)(out + (size_t)m * DMODEL) + lane; u32x2* o2 = (u32x2*)(out + (size_t)m2 * DMODEL) + lane;
#pragma unroll
        for (int j = 0; j < 4; ++j) { const f32x4 g = ((const f32x4*)gain)[64 * j + lane]; const f32x4 y = v[j] * rs * g, y2 = w[j] * rs2 * g; o[64 * j] = (u32x2){pk2(y.x, y.y), pk2(y.z, y.w)}; o2[64 * j] = (u32x2){pk2(y2.x, y2.y), pk2(y2.z, y2.w)}; }
    }
}
__device__ __forceinline__ void rms_rows_f32(float* x, const float* gain, int gw, int NGW, int lane) {
    for (int m = gw; m < MTOK; m += 2 * NGW) {
        const int m2 = (m + NGW < MTOK) ? m + NGW : m;
        f32x4* xr = (f32x4*)(x + (size_t)m * DMODEL) + lane; f32x4* xr2 = (f32x4*)(x + (size_t)m2 * DMODEL) + lane; f32x4 v[4], w[4]; float s = 0.f, s2 = 0.f;
#pragma unroll
        for (int j = 0; j < 4; ++j) { v[j] = xr[64 * j]; w[j] = xr2[64 * j]; }
#pragma unroll
        for (int j = 0; j < 4; ++j) { s += (v[j].x * v[j].x + v[j].y * v[j].y) + (v[j].z * v[j].z + v[j].w * v[j].w); s2 += (w[j].x * w[j].x + w[j].y * w[j].y) + (w[j].z * w[j].z + w[j].w * w[j].w); }
        const float rs = 1.0f / sqrtf(wave_sum(s) * (1.0f / DMODEL) + EPS), rs2 = 1.0f / sqrtf(wave_sum(s2) * (1.0f / DMODEL) + EPS);
#pragma unroll
        for (int j = 0; j < 4; ++j) { const f32x4 g = ((const f32x4*)gain)[64 * j + lane]; xr[64 * j] = v[j] * rs * g; if (m2 != m) xr2[64 * j] = w[j] * rs2 * g; }
    }
}

__device__ __forceinline__ void phase0(const KA& a, int layer, const float* xin, LAS unsigned char* lds, int tid0, int, int) {
    asm volatile("" : "+v"(tid0)); const int tid = tid0, lane = tid & 63, wid = __builtin_amdgcn_readfirstlane(tid >> 6);
    unsigned char* ws = a.ws;
    const int gw = blockIdx.x * 8 + wid, NGW = gridDim.x * 8;
    LAS float* scr = (LAS float*)(lds + wid * 16384);
    if (gw == 0) { const float* lq1 = (const float*)a.in[10] + layer * 64; const float* lk1 = (const float*)a.in[11] + layer * 64; const float* lq2 = (const float*)a.in[12] + layer * 64; const float* lk2 = (const float*)a.in[13] + layer * 64;
        const float lambda_init = 0.8f - 0.6f * expf(-0.3f * (float)layer); const float s1 = wave_sum(lq1[lane] * lk1[lane]), s2 = wave_sum(lq2[lane] * lk2[lane]);
        if (lane == 0) { ((float*)(ws + WS_LAM))[0] = expf(s1) - expf(s2) + lambda_init; ((float*)(ws + WS_LAM))[1] = 1.0f - lambda_init; } }
    const float* w_in = (const float*)a.in[3] + (size_t)layer * DMODEL * DIN;
    const float* w_merge = (const float*)a.in[21] + (size_t)layer * DMODEL * 3072;
    conv_items((bf16_t*)(ws + WS_WCAT), 1024, NCAT, [=](int n, const float*& cp, int& ld) {
        const int t = n >> 8, w = n & 255; ld = DIN; int col = -1;
        if (t < 2) col = (n >> 6) * 64 + rope_perm(n & 63);
        else if (t == 2) col = 512 + w;
        else if (t == 3) col = (w < 128) ? 768 + (w >> 6) * 64 + rope_perm(w & 63) : 896 + (w - 128);
        else if (t == 4) col = (w < 128) ? 1024 + (w >> 6) * 64 + rope_perm(w & 63) : 1152 + (w - 128);
        else if (t < 7) { const int p = n - 1280; col = 1304 + (p >> 6) * 64 + rope_perm(p & 63); }
        else if (t < 9) { const int p = n - 1792; col = 1816 + (p >> 6) * 64 + rope_perm(p & 63); }
        else if (t < 11) col = 2328 + (n - 2304);
        else if (t < 15) col = 2840 + (n - 2816);
        else if (t < 27) { ld = 3072; cp = w_merge + (n - 3840); return; }
        else col = (w < 24) ? 1280 + w : -1;
        cp = col >= 0 ? w_in + col : nullptr; }, scr, gw, NGW, lane);
#pragma unroll
    for (int br = 0; br < 3; ++br) { const float* wb = (const float*)a.in[18 + br] + (size_t)layer * 512 * 1024;
        conv_items((bf16_t*)(ws + WS_WBR) + (size_t)br * 1024 * 512, 512, 1024, [=](int n, const float*& cp, int& ld) { ld = 1024; cp = wb + n; }, scr, gw, NGW, lane); }
    { const float* wo = (const float*)a.in[23] + (size_t)layer * 1024 * 1024;
      conv_items((bf16_t*)(ws + WS_WOUT), 1024, 1024, [=](int n, const float*& cp, int& ld) { ld = 1024; cp = wo + n; }, scr, gw, NGW, lane); }
    { const float* w1 = (const float*)a.in[25] + (size_t)layer * 1024 * DFF; const float* w3 = (const float*)a.in[26] + (size_t)layer * 1024 * DFF;
      conv_items((bf16_t*)(ws + WS_W13), 1024, NFF13, [=](int n, const float*& cp, int& ld) { const int t = n >> 8, w = n & 255; ld = DFF; const long d31 = w3 - w1; cp = w1 + ((long)(t * 128 + (w & 127)) + ((w < 128) ? 0L : d31)); }, scr, gw, NGW, lane); }
    { const float* w2 = (const float*)a.in[27] + (size_t)layer * DFF * 1024;
      conv_items((bf16_t*)(ws + WS_W2), DFF, 1024, [=](int n, const float*& cp, int& ld) { ld = 1024; cp = w2 + n; }, scr, gw, NGW, lane); }
#pragma unroll
    for (int which = 0; which < 2; ++which) {
        const float* c1 = (const float*)a.in[which ? 8 : 5] + (size_t)layer * 2048 * 256; const float* c2 = (const float*)a.in[which ? 9 : 6] + (size_t)layer * 256 * 64;
        conv_items((bf16_t*)(ws + WS_WC1) + (size_t)which * 256 * 2048, 2048, 256, [=](int n, const float*& cp, int& ld) { ld = 256; cp = c1 + n; }, scr, gw, NGW, lane);
        conv_items((bf16_t*)(ws + WS_WC2) + (size_t)which * 64 * 256, 256, 64, [=](int n, const float*& cp, int& ld) { ld = 64; cp = c2 + (which ? n : rope_perm(n)); }, scr, gw, NGW, lane);
        const float* pos = (const float*)a.in[which ? 7 : 4] + (size_t)layer * 2048;
        for (int it = gw; it < 64; it += NGW) { const int jb = it & 3, kp = it >> 2; float s = 0.f;
#pragma unroll 8
            for (int k = kp * 128; k < kp * 128 + 128; ++k) s += pos[k] * c1[(size_t)k * 256 + jb * 64 + lane];
            ((float*)(ws + WS_BIAS1))[(which * 16 + kp) * 256 + jb * 64 + lane] = s; }
    }
    rms_rows_bf16(xin, (const float*)a.in[2] + (size_t)layer * DMODEL, (bf16_t*)(ws + WS_H64), gw, NGW, lane);
}

__device__ __forceinline__ void rope_table(const KA& a, int tid0) {
    asm volatile("" : "+v"(tid0)); const int tid = tid0; unsigned char* ws = a.ws;
    {
        const int* positions = (const int*)a.in[1]; float* cosT = (float*)(ws + WS_COS); float* sinT = (float*)(ws + WS_SIN);
        for (int e = blockIdx.x * 512 + tid; e < MTOK * 32; e += gridDim.x * 512) { const int m = e >> 5, i = e & 31;
            double pw = 1.0; for (int k = 0; k < i; ++k) pw *= 0.7498942093324559;
            const float inv = (float)pw; const float ang = (float)positions[m] * inv;
            const double ad = (double)ang; const double kq = __builtin_rint(ad * 0.6366197723675814);
            const double y = (ad - kq * 1.5707963267341256) - kq * 6.077100506506192e-11, z = y * y;
            const double sy = y + y * z * (-0.166666666416265235595 + z * (0.0083333293858894631756 + z * (-0.000198393348360966317347 + z * 0.0000027183114939898219064)));
            const double cy = 1.0 + z * (-0.499999997251031003120 + z * (0.0416666233237390631894 + z * (-0.00138867637746099294692 + z * 0.0000243904487962774090654)));
            const int qd = ((int)kq) & 3; const double sn = (qd == 0) ? sy : (qd == 1) ? cy : (qd == 2) ? -sy : -cy, cs = (qd == 0) ? cy : (qd == 1) ? -sy : (qd == 2) ? -cy : sy;
            cosT[e] = (float)cs; sinT[e] = (float)sn; }
    }
}

__device__ __forceinline__ void compress_unit(const KA& a, int unit, LAS unsigned char* lds, int tid0, int, int) {
    asm volatile("" : "+v"(tid0)); const int tid = tid0, lane = tid & 63, wid = __builtin_amdgcn_readfirstlane(tid >> 6);
    unsigned char* ws = a.ws;
    const int which = unit >> 7, b = (unit >> 5) & 3, g = (unit >> 4) & 1, n0 = (unit & 15) * 32;
    const bf16_t* src = (const bf16_t*)(ws + (which ? WS_VCMP : WS_KCMP));
    const bf16_t* W1t = (const bf16_t*)(ws + WS_WC1) + (size_t)which * 256 * 2048; const bf16_t* W2t = (const bf16_t*)(ws + WS_WC2) + (size_t)which * 64 * 256;
    const float* bias1 = (const float*)(ws + WS_BIAS1) + which * 16 * 256;
    constexpr int HST = 264; LAS bf16_t* H1 = (LAS bf16_t*)lds;
    const int fr = lane & 15, q = lane >> 4, j0 = 32 * wid;
    f32x4 acc[2][2];
#pragma unroll
    for (int i = 0; i < 2; ++i)
#pragma unroll
        for (int j = 0; j < 2; ++j) acc[i][j] = (f32x4){0.f, 0.f, 0.f, 0.f};
#pragma unroll 4
    for (int ks = 0; ks < 64; ++ks) { const int k0 = 32 * ks + 8 * q, l = k0 >> 6, d = k0 & 63; bf16x8 af[2], bfr[2];
#pragma unroll
        for (int mt = 0; mt < 2; ++mt) { int tok = 16 * (n0 + 16 * mt + fr) + l; tok = tok < SEQ ? tok : SEQ - 1; af[mt] = *(const bf16x8*)(src + ((size_t)b * SEQ + tok) * 128 + g * 64 + d); }
#pragma unroll
        for (int nt = 0; nt < 2; ++nt) bfr[nt] = *(const bf16x8*)(W1t + (size_t)(j0 + 16 * nt + fr) * 2048 + k0);
#pragma unroll
        for (int mt = 0; mt < 2; ++mt)
#pragma unroll
            for (int nt = 0; nt < 2; ++nt) acc[mt][nt] = mfma16(af[mt], bfr[nt], acc[mt][nt]);
    }
#pragma unroll
    for (int mt = 0; mt < 2; ++mt)
#pragma unroll
        for (int nt = 0; nt < 2; ++nt) { const int j = j0 + 16 * nt + fr; float bj = 0.f;
#pragma unroll
            for (int p = 0; p < 16; ++p) bj += bias1[p * 256 + j];
#pragma unroll
            for (int i = 0; i < 4; ++i) { const float h = pg8::gelu_tanh(acc[mt][nt][i] + bj); H1[(16 * mt + 4 * q + i) * HST + j] = (bf16_t)(pk2(h, 0.f) & 0xffffu); } }
    __syncthreads();
    { const int mt = wid >> 2, dt = wid & 3; f32x4 o = (f32x4){0.f, 0.f, 0.f, 0.f};
#pragma unroll
      for (int ks = 0; ks < 8; ++ks) { const bf16x8 af = *(const LAS bf16x8*)(H1 + (16 * mt + fr) * HST + 32 * ks + 8 * q); const bf16x8 bf = *(const bf16x8*)(W2t + (size_t)(16 * dt + fr) * 256 + 32 * ks + 8 * q); o = mfma16(af, bf, o); }
      const int bg = b * 2 + g, d = 16 * dt + fr, nb = n0 + 16 * mt + 4 * q;
      if (which == 0) { bf16_t* kc = (bf16_t*)(ws + WS_KC) + (size_t)bg * 512 * 64;
#pragma unroll
          for (int i = 0; i < 4; ++i) kc[(size_t)(nb + i) * 64 + d] = (nb + i < 511) ? (bf16_t)(pk2(o[i], 0.f) & 0xffffu) : (bf16_t)0; }
      else { bf16_t* vct = (bf16_t*)(ws + WS_VCT) + (size_t)bg * 64 * 512; if (nb + 3 >= 511) o[3] = 0.f;
          *(u32x2*)(vct + (size_t)d * 512 + nb) = (u32x2){pk2(o[0], o[1]), pk2(o[2], o[3])}; }
    }
    __syncthreads();
}

__device__ __forceinline__ void sgu_unit(const KA& a, int layer, int unit, LAS unsigned char* lds, int tid0, int, int, bf16_t* dstb) {
    asm volatile("" : "+v"(tid0)); const int tid = tid0, lane = tid & 63, wid = __builtin_amdgcn_readfirstlane(tid >> 6);
    unsigned char* ws = a.ws;
    const bf16_t* ub = (const bf16_t*)(ws + WS_U); const bf16_t* vb = (const bf16_t*)(ws + WS_V);
    const float* gain = (const float*)a.in[15] + (size_t)layer * 512; const float* wsp = (const float*)a.in[16] + (size_t)layer * 4 * 128 * 128; const float* bsp = (const float*)a.in[17] + (size_t)layer * 4 * 128;
    constexpr int VST = 144, UST = 136; LAS bf16_t* vL = (LAS bf16_t*)lds; LAS bf16_t* uL = (LAS bf16_t*)(lds + 128 * VST * 2); LAS float* rstat = (LAS float*)(lds + 128 * VST * 2 + 128 * UST * 2);
    typedef short v4i16_t __attribute__((ext_vector_type(4)));
    const size_t row0 = (size_t)unit * 128; const int fr = lane & 15, q = lane >> 4;
    { u32x4 x[16];
#pragma unroll
      for (int rr = 0; rr < 16; ++rr) x[rr] = *(const u32x4*)(vb + (row0 + wid * 16 + rr) * 512 + lane * 8);
#pragma unroll
      for (int rr = 0; rr < 16; ++rr) { float s = 0.f;
#pragma unroll
          for (int k = 0; k < 4; ++k) { const float lo = bflo(x[rr][k]), hi = bfhi(x[rr][k]); s += lo * lo + hi * hi; }
          s = wave_sum(s); if (lane == 0) rstat[wid * 16 + rr] = 1.0f / sqrtf(s * (1.0f / 512.0f) + EPS); } }
    __syncthreads();
    u32x4 xv[4], xu[4];
#pragma unroll
    for (int it = 0; it < 4; ++it) { const int idx = tid + 512 * it, s = idx >> 4, c8 = (idx & 15) * 8; xv[it] = *(const u32x4*)(vb + (row0 + s) * 512 + c8); xu[it] = *(const u32x4*)(ub + (row0 + s) * 512 + c8); }
#pragma unroll 1
    for (int g = 0; g < 4; ++g) {
        {
#pragma unroll
          for (int it = 0; it < 4; ++it) { const int idx = tid + 512 * it, s = idx >> 4, c8 = (idx & 15) * 8; const float rs = rstat[s];
              const f32x4 g0 = *(const f32x4*)(gain + g * 128 + c8), g1 = *(const f32x4*)(gain + g * 128 + c8 + 4);
              u32x4 o; o.x = pk2(bflo(xv[it].x) * rs * g0.x, bfhi(xv[it].x) * rs * g0.y); o.y = pk2(bflo(xv[it].y) * rs * g0.z, bfhi(xv[it].y) * rs * g0.w);
              o.z = pk2(bflo(xv[it].z) * rs * g1.x, bfhi(xv[it].z) * rs * g1.y); o.w = pk2(bflo(xv[it].w) * rs * g1.z, bfhi(xv[it].w) * rs * g1.w);
              *(LAS u32x4*)(vL + s * VST + c8) = o; *(LAS u32x4*)(uL + s * UST + c8) = xu[it]; } }
        __syncthreads();
        if (g < 3) {
#pragma unroll
            for (int it = 0; it < 4; ++it) { const int idx = tid + 512 * it, s = idx >> 4, c8 = (idx & 15) * 8; xv[it] = *(const u32x4*)(vb + (row0 + s) * 512 + (g + 1) * 128 + c8); xu[it] = *(const u32x4*)(ub + (row0 + s) * 512 + (g + 1) * 128 + c8); } }
        const int t0 = 16 * wid; f32x4 acc[8];
#pragma unroll
        for (int ct = 0; ct < 8; ++ct) acc[ct] = (f32x4){0.f, 0.f, 0.f, 0.f};
#pragma unroll
        for (int ks = 0; ks < 4; ++ks) { if (32 * ks <= t0 + 15) {
            const int t = t0 + fr, s0 = 32 * ks + 8 * q; const float* wr = wsp + ((size_t)g * 128 + t) * 128 + s0; const f32x4 w0 = *(const f32x4*)wr, w1 = *(const f32x4*)(wr + 4);
            float wv[8] = {w0.x, w0.y, w0.z, w0.w, w1.x, w1.y, w1.z, w1.w};
#pragma unroll
            for (int k = 0; k < 8; ++k) wv[k] = (s0 + k <= t) ? wv[k] : 0.f;
            const u32x4 ap = (u32x4){pk2(wv[0], wv[1]), pk2(wv[2], wv[3]), pk2(wv[4], wv[5]), pk2(wv[6], wv[7])}; const bf16x8 af = __builtin_bit_cast(bf16x8, ap);
            const LAS bf16_t* vp = vL + (s0 + (fr >> 2)) * VST + 4 * (fr & 3);
#pragma unroll
            for (int ct = 0; ct < 8; ++ct) { const v4i16_t b0 = __builtin_amdgcn_ds_read_tr16_b64_v4i16((LAS v4i16_t*)(vp + 16 * ct)), b1 = __builtin_amdgcn_ds_read_tr16_b64_v4i16((LAS v4i16_t*)(vp + 4 * VST + 16 * ct));
                const bf16x8 bf = (bf16x8){b0[0], b0[1], b0[2], b0[3], b1[0], b1[1], b1[2], b1[3]}; acc[ct] = mfma16(af, bf, acc[ct]); } } }
#pragma unroll
        for (int ct = 0; ct < 8; ++ct)
#pragma unroll
            for (int i = 0; i < 4; ++i) { const int t = t0 + 4 * q + i; LAS bf16_t* up = uL + t * UST + ct * 16 + fr; const float uval = __uint_as_float(((unsigned)*up) << 16);
                *up = (bf16_t)(pk2((acc[ct][i] + bsp[g * 128 + t]) * uval, 0.f) & 0xffffu); }
        LDS_WAIT();
#pragma unroll
        for (int it = 0; it < 4; ++it) { const int r = t0 + it * 4 + (lane >> 4), c8 = (lane & 15) * 8; *(u32x4*)(dstb + (row0 + r) * 512 + g * 128 + c8) = *(const LAS u32x4*)(uL + r * UST + c8); }
        __syncthreads();
    }
}

__device__ __forceinline__ float dpp_xor1(float v) { return __int_as_float(__builtin_amdgcn_update_dpp(0, __float_as_int(v), 0xB1, 0xF, 0xF, true)); }
__device__ __forceinline__ float dpp_xor2(float v) { return __int_as_float(__builtin_amdgcn_update_dpp(0, __float_as_int(v), 0x4E, 0xF, 0xF, true)); }
__device__ __forceinline__ void cmp_phase(const KA& a, LAS unsigned char* lds, int tid0, int, int) {
    asm volatile("" : "+v"(tid0)); const int tid = tid0, lane = tid & 63, wid = __builtin_amdgcn_readfirstlane(tid >> 6);
    unsigned char* ws = a.ws;
    const bf16_t* qa = (const bf16_t*)(ws + WS_QA); bf16_t* ocmp = (bf16_t*)(ws + WS_OCMP); u32x4* selp = (u32x4*)(ws + WS_SEL);
    constexpr int KST = 72, VST = 516;
    LAS bf16_t* kcL = (LAS bf16_t*)lds; LAS bf16_t* vcL = (LAS bf16_t*)(lds + 512 * KST * 2); LAS float* scr = (LAS float*)(lds + 512 * KST * 2 + 64 * VST * 2) + wid * 512;
    const int fr = lane & 15, rq = lane >> 4, tok = fr >> 2, head = fr & 3;
    for (int v = blockIdx.x; v < 256; v += gridDim.x) {
        const int bg = v >> 5, b = bg >> 1, g = bg & 1, chunk = v & 31;
        __syncthreads();
        const bf16_t* kcg = (const bf16_t*)(ws + WS_KC) + (size_t)bg * 512 * 64; const bf16_t* vcg = (const bf16_t*)(ws + WS_VCT) + (size_t)bg * 64 * 512;
        for (int it = tid; it < 4096; it += 512) { const int r = it >> 3, c = it & 7; *(LAS u32x4*)(kcL + r * KST + c * 8) = *(const u32x4*)(kcg + r * 64 + c * 8); }
        for (int it = tid; it < 4096; it += 512) { const int r = it >> 6, c = it & 63; const u32x4 x = *(const u32x4*)(vcg + r * 512 + c * 8); LAS u32x2* d = (LAS u32x2*)(vcL + r * VST + c * 8); d[0] = (u32x2){x.x, x.y}; d[1] = (u32x2){x.z, x.w}; }
        __syncthreads();
        bf16x8 qnx[2];
        { const int t0n = chunk * 32 + wid * 4; const size_t grown = (size_t)b * SEQ + t0n + tok;
#pragma unroll
          for (int ks = 0; ks < 2; ++ks) qnx[ks] = *(const bf16x8*)(qa + grown * 512 + (4 * g + head) * 64 + 32 * ks + 8 * rq); }
        for (int it = 0; it < 8; ++it) {
            const int t0 = (it * 32 + chunk) * 32 + wid * 4, t = t0 + tok; const size_t grow = (size_t)b * SEQ + t;
            bf16x8 qf[2]; qf[0] = qnx[0]; qf[1] = qnx[1];
            if (it < 7) { const size_t grown = (size_t)b * SEQ + ((it + 1) * 32 + chunk) * 32 + wid * 4 + tok;
#pragma unroll
                for (int ks = 0; ks < 2; ++ks) qnx[ks] = *(const bf16x8*)(qa + grown * 512 + (4 * g + head) * 64 + 32 * ks + 8 * rq); }
            const int nmax = (t >= 31) ? ((t - 31) >> 4) : -1, nmw = (t0 + 3 >= 31) ? ((t0 + 3 - 31) >> 4) : -1, ntc = (nmw >> 4) + 1;
            float m = -INFINITY, l = 0.f;
#pragma unroll 2
            for (int nt = 0; nt < ntc; ++nt) { const bf16x8 a0 = *(const LAS bf16x8*)(kcL + (16 * nt + fr) * KST + 8 * rq), a1 = *(const LAS bf16x8*)(kcL + (16 * nt + fr) * KST + 32 + 8 * rq);
                f32x4 sv = mfma16(a0, qf[0], (f32x4){0.f, 0.f, 0.f, 0.f}); sv = mfma16(a1, qf[1], sv);
#pragma unroll
                for (int i = 0; i < 4; ++i) sv[i] = (16 * nt + 4 * rq + i <= nmax) ? sv[i] : -INFINITY;
                const float mn = fmaxf(fmaxf(m, fmaxf(sv[0], sv[1])), fmaxf(sv[2], sv[3])), ms = (mn == -INFINITY) ? 0.f : mn;
                l = l * __builtin_amdgcn_exp2f(m - ms) + ((__builtin_amdgcn_exp2f(sv[0] - ms) + __builtin_amdgcn_exp2f(sv[1] - ms)) + (__builtin_amdgcn_exp2f(sv[2] - ms) + __builtin_amdgcn_exp2f(sv[3] - ms)));
                m = mn; }
            float M = fmaxf(m, __shfl_xor(m, 16)); M = fmaxf(M, __shfl_xor(M, 32)); const float Ms = (M == -INFINITY) ? 0.f : M;
            l = l * __builtin_amdgcn_exp2f(m - Ms); l += __shfl_xor(l, 16); l += __shfl_xor(l, 32);
            const float inv = l > 0.f ? 1.0f / l : 0.f;
            f32x4 O[4];
#pragma unroll
            for (int dt = 0; dt < 4; ++dt) O[dt] = (f32x4){0.f, 0.f, 0.f, 0.f};
            float zprev = 0.f;
#pragma unroll
            for (int z8 = 0; z8 < 8; ++z8) scr[z8 * 64 + lane] = 0.f;
            const int kkc = (ntc / 2 + 1) < 16 ? (ntc / 2 + 1) : 16;
#pragma unroll 1
            for (int kk = 0; kk < kkc; ++kk) { const int nt0 = 2 * kk; f32x4 pp[2];
#pragma unroll
                for (int h2 = 0; h2 < 2; ++h2) { const int nt = nt0 + h2; pp[h2] = (f32x4){0.f, 0.f, 0.f, 0.f};
                    if (nt < ntc) { const bf16x8 a0 = *(const LAS bf16x8*)(kcL + (16 * nt + fr) * KST + 8 * rq), a1 = *(const LAS bf16x8*)(kcL + (16 * nt + fr) * KST + 32 + 8 * rq);
                        f32x4 sv = mfma16(a0, qf[0], (f32x4){0.f, 0.f, 0.f, 0.f}); sv = mfma16(a1, qf[1], sv);
#pragma unroll
                        for (int i = 0; i < 4; ++i) pp[h2][i] = (16 * nt + 4 * rq + i <= nmax) ? __builtin_amdgcn_exp2f(sv[i] - Ms) * inv : 0.f; } }
                if (nt0 < ntc) { const u32x4 ap = (u32x4){pk2(pp[0][0], pp[0][1]), pk2(pp[0][2], pp[0][3]), pk2(pp[1][0], pp[1][1]), pk2(pp[1][2], pp[1][3])}; const bf16x8 af = __builtin_bit_cast(bf16x8, ap);
#pragma unroll
                    for (int dt = 0; dt < 4; ++dt) { const LAS bf16_t* vp = vcL + (16 * dt + fr) * VST + 16 * nt0 + 4 * rq; const u32x2 p0 = *(const LAS u32x2*)vp, p1 = *(const LAS u32x2*)(vp + 16);
                        const u32x4 bp = (u32x4){p0.x, p0.y, p1.x, p1.y}; O[dt] = mfma16(af, __builtin_bit_cast(bf16x8, bp), O[dt]); } }
#pragma unroll
                for (int h2 = 0; h2 < 2; ++h2) { const int nt = nt0 + h2;
                    float s4 = (pp[h2][0] + pp[h2][1]) + (pp[h2][2] + pp[h2][3]), s3 = pp[h2][3];
                    s4 += dpp_xor1(s4); s4 += dpp_xor2(s4); s3 += dpp_xor1(s3); s3 += dpp_xor2(s3);
                    const float z = __shfl(s3, (lane - 16) & 63);
                    const float imp = s4 + (rq > 0 ? z : zprev); zprev = z;
                    if (head == 0) scr[tok * 128 + 4 * nt + rq] = imp; }
            }
#pragma unroll
            for (int dt = 0; dt < 4; ++dt)
#pragma unroll
                for (int i = 0; i < 4; ++i) ocmp[((size_t)b * SEQ + t0 + rq) * 512 + (4 * g + i) * 64 + 16 * dt + fr] = (bf16_t)(pk2(O[dt][i], 0.f) & 0xffffu);
            LDS_WAIT();
            {
                unsigned k0[4], k1[4], T[4]; int Rr[4];
#pragma unroll
                for (int tk = 0; tk < 4; ++tk) { const int cu = (t0 + tk) >> 6; const float a0 = scr[tk * 128 + lane], a1 = scr[tk * 128 + 64 + lane]; const int j1 = lane + 64;
                    const bool f0 = (lane == 0) || (lane == cu) || (lane == cu - 1), f1 = (j1 == cu) || (j1 == cu - 1);
                    const bool c0 = (lane <= cu) && !f0, c1 = (j1 <= cu) && !f1;
                    k0[tk] = c0 ? (__float_as_uint(a0) | 0x80000000u) : 0u; k1[tk] = c1 ? (__float_as_uint(a1) | 0x80000000u) : 0u;
                    T[tk] = 0x80000000u; Rr[tk] = 16 - ((cu == 0) ? 1 : (cu == 1) ? 2 : 3); }
#pragma unroll 1
                for (int bit = 30; bit >= 0; --bit) {
#pragma unroll
                    for (int tk = 0; tk < 4; ++tk) { const unsigned tr = T[tk] | (1u << bit);
                        const int cnt = __popcll(__ballot(k0[tk] >= tr)) + __popcll(__ballot(k1[tk] >= tr)); T[tk] = (cnt >= Rr[tk]) ? tr : T[tk]; } }
#pragma unroll
                for (int tk = 0; tk < 4; ++tk) { const int tt = t0 + tk, cu = tt >> 6; const int j1 = lane + 64;
                    const bool f0 = (lane == 0) || (lane == cu) || (lane == cu - 1), f1 = (j1 == cu) || (j1 == cu - 1);
                    const unsigned Tt = T[tk];
                    const unsigned long long g0 = __ballot(k0[tk] > Tt), g1 = __ballot(k1[tk] > Tt), e0 = __ballot(k0[tk] == Tt), e1 = __ballot(k1[tk] == Tt);
                    const int need = Rr[tk] - (__popcll(g0) + __popcll(g1)), need1 = need - __popcll(e0);
                    const int p0 = __builtin_amdgcn_mbcnt_hi((unsigned)(e0 >> 32), __builtin_amdgcn_mbcnt_lo((unsigned)e0, 0u)), p1 = __builtin_amdgcn_mbcnt_hi((unsigned)(e1 >> 32), __builtin_amdgcn_mbcnt_lo((unsigned)e1, 0u));
                    const bool s0 = (k0[tk] > Tt) || (k0[tk] == Tt && p0 < need), s1 = (k1[tk] > Tt) || (k1[tk] == Tt && p1 < need1);
                    const unsigned long long m0 = __ballot(f0 || s0), m1 = __ballot(f1 || s1);
                    if (lane == 0) selp[((size_t)b * SEQ + tt) * 2 + g] = (u32x4){(unsigned)m0, (unsigned)(m0 >> 32), (unsigned)m1, (unsigned)(m1 >> 32)}; }
            }
            LDS_WAIT();
        }
    }
    __syncthreads();
}

__device__ __forceinline__ void diff_post(const KA& a, int layer, float lambda_init, int tid0) {
    asm volatile("" : "+v"(tid0)); const int lane = tid0 & 63, wid = __builtin_amdgcn_readfirstlane(tid0 >> 6);
    unsigned char* ws = a.ws; const int gw = blockIdx.x * 8 + wid, NGW = gridDim.x * 8;
    const float* lq1 = (const float*)a.in[10] + layer * 64; const float* lk1 = (const float*)a.in[11] + layer * 64; const float* lq2 = (const float*)a.in[12] + layer * 64; const float* lk2 = (const float*)a.in[13] + layer * 64;
    const float s1 = wave_sum(lq1[lane] * lk1[lane]), s2 = wave_sum(lq2[lane] * lk2[lane]);
    const float lam = expf(s1) - expf(s2) + lambda_init, post = 1.0f - lambda_init;
    const bf16_t* dO = (const bf16_t*)(ws + WS_H64); bf16_t* ob = (bf16_t*)(ws + WS_QB);
    const int h = lane >> 4, e0 = (lane & 15) * 8; const float* sg = (const float*)a.in[14] + layer * 128 + e0;
    const f32x4 g0 = *(const f32x4*)sg, g1 = *(const f32x4*)(sg + 4);
    for (int m0 = gw; m0 < MTOK; m0 += 4 * NGW) {
        u32x4 o1[4], o2[4];
#pragma unroll
        for (int r = 0; r < 4; ++r) { const int m = (m0 + r * NGW < MTOK) ? m0 + r * NGW : m0; o1[r] = *(const u32x4*)(dO + (size_t)m * 1024 + h * 256 + e0); o2[r] = *(const u32x4*)(dO + (size_t)m * 1024 + h * 256 + 128 + e0); }
#pragma unroll
        for (int r = 0; r < 4; ++r) { const int m = (m0 + r * NGW < MTOK) ? m0 + r * NGW : m0; float v[8]; float ss = 0.f;
#pragma unroll
            for (int k = 0; k < 4; ++k) { v[2 * k] = bflo(o1[r][k]) - lam * bflo(o2[r][k]); v[2 * k + 1] = bfhi(o1[r][k]) - lam * bfhi(o2[r][k]); ss += v[2 * k] * v[2 * k] + v[2 * k + 1] * v[2 * k + 1]; }
            ss += __shfl_xor(ss, 1); ss += __shfl_xor(ss, 2); ss += __shfl_xor(ss, 4); ss += __shfl_xor(ss, 8);
            const float rs = post / sqrtf(ss * (1.0f / 128.0f) + EPS);
            *(u32x4*)(ob + (size_t)m * 512 + h * 128 + e0) = (u32x4){pk2(v[0] * rs * g0.x, v[1] * rs * g0.y), pk2(v[2] * rs * g0.z, v[3] * rs * g0.w), pk2(v[4] * rs * g1.x, v[5] * rs * g1.y), pk2(v[6] * rs * g1.z, v[7] * rs * g1.w)}; }
    }
}

#define XB_TMO      128
#define XB_XCNT(j)  (256  + 64 * (j))
#define XB_XSUB(j)  (1280 + 64 * (j))
#define XB_XGEN(j)  (2304 + 64 * (j))
#define XB_TOP      3328
#define XB_TOPGEN   3392
#define XCD_BAR_WORDS 3456
#define XB_SPIN_CAP (1u << 18)

__device__ __forceinline__ unsigned xb_ld(unsigned* p)              { return __hip_atomic_load(p, __ATOMIC_RELAXED, __HIP_MEMORY_SCOPE_AGENT); }
__device__ __forceinline__ unsigned xb_add(unsigned* p, unsigned v) { return __hip_atomic_fetch_add(p, v, __ATOMIC_RELAXED, __HIP_MEMORY_SCOPE_AGENT); }
__device__ __forceinline__ unsigned xb_xcc_id() { return (unsigned)__builtin_amdgcn_s_getreg((3 << 11) | 20) & 0xFu; }
#define XB_SPIN(cond, bar) do { unsigned _sp = 0; while (cond) { __builtin_amdgcn_s_sleep(1); \
    if ((++_sp & 255u) == 0u) { if (xb_ld(&(bar)[XB_TMO])) break; if (_sp > XB_SPIN_CAP) { atomicAdd(&(bar)[XB_TMO], 1u); break; } } } } while (0)

struct XcdBarrier {
    unsigned* bar; unsigned x;
    volatile LAS unsigned* st;
};

__device__ __forceinline__ XcdBarrier xcd_barrier_post(unsigned* bar, volatile LAS unsigned* st) {
    XcdBarrier b; b.bar = bar; b.x = xb_xcc_id(); b.st = st;
    if (threadIdx.x == 0) (void)xb_add(&bar[XB_XCNT(b.x)], 1u);
    return b;
}
__device__ __forceinline__ void xcd_barrier_complete(unsigned* bar, unsigned x, unsigned& nloc, unsigned& nx) {
    const unsigned G = gridDim.x * gridDim.y * gridDim.z;
    unsigned sum, cnt, mine, sp = 0u;
    for (;;) {
        sum = 0u; cnt = 0u; mine = 0u;
#pragma unroll
        for (unsigned j = 0; j < 16; ++j) { const unsigned c = xb_ld(&bar[XB_XCNT(j)]); sum += c; cnt += (c > 0u) ? 1u : 0u; mine = (j == x) ? c : mine; }
        if (sum == G) break;
        __builtin_amdgcn_s_sleep(1);
        if ((++sp & 255u) == 0u) { if (xb_ld(&bar[XB_TMO])) break; if (sp > XB_SPIN_CAP) { atomicAdd(&bar[XB_TMO], 1u); break; } }
    }
    nloc = mine > 0u ? mine : 1u; nx = cnt > 0u ? cnt : 1u;
}

__device__ __forceinline__ void xcd_barrier(const XcdBarrier& b) {
    asm volatile("s_waitcnt vmcnt(0)" ::: "memory");
    __syncthreads();
    if (threadIdx.x == 0) {
        unsigned* bar = b.bar;
        __builtin_amdgcn_s_waitcnt(0);
        unsigned nloc = b.st[0], nx = b.st[1];
        if (nloc == 0u) { xcd_barrier_complete(bar, b.x, nloc, nx); b.st[0] = nloc; b.st[1] = nx; }
        const unsigned old = xb_add(&bar[XB_XSUB(b.x)], 1u);
        const unsigned gen = old / nloc;
        if (old + 1u == (gen + 1u) * nloc) {
            __builtin_amdgcn_fence(__ATOMIC_RELEASE, "agent");
            asm volatile("s_waitcnt vmcnt(0)" ::: "memory");
            const unsigned og = xb_add(&bar[XB_TOP], 1u);
            const unsigned tg = og / nx;
            if (og + 1u == (tg + 1u) * nx) xb_add(&bar[XB_TOPGEN], 1u);
            else XB_SPIN(xb_ld(&bar[XB_TOPGEN]) == tg, bar);
            __builtin_amdgcn_fence(__ATOMIC_ACQUIRE, "agent");
            xb_add(&bar[XB_XGEN(b.x)], 1u);
            asm volatile("s_waitcnt vmcnt(0)" ::: "memory");
        } else {
            XB_SPIN(xb_ld(&bar[XB_XGEN(b.x)]) == gen, bar);
            __builtin_amdgcn_fence(__ATOMIC_ACQUIRE, "agent");
            asm volatile("s_waitcnt vmcnt(0)" ::: "memory");
        }
    }
    __syncthreads();
}

#ifndef PHM
#define PHM 0x7df
#endif
#ifndef DBL
#define DBL 0
#endif
#define GSYNC() do { xcd_barrier(bar); if ((DBL >> 15) & 1) xcd_barrier(bar); } while (0)
#define NREP(bit) ((((DBL) >> (bit)) & 1) ? 2 : 1)
#define PHASE_WS const KA a = make_ka(); unsigned char* ws = a.ws; bf16_t* H64 = (bf16_t*)(ws + WS_H64); const float* cosT = (const float*)(ws + WS_COS); const float* sinT = (const float*)(ws + WS_SIN); (void)H64; (void)cosT; (void)sinT;
template <int layer> __device__ __forceinline__ void run_layer(LAS unsigned char* lds, unsigned char* lds_raw, const XcdBarrier& bar, int tid, int lane, int wid, int G, int bx) {
        const float lambda_init = 0.8f - 0.6f * expf(-0.3f * (float)layer);
#if (PHM >> 0) & 1
_Pragma("unroll 1")
        for (int rep_ = 0; rep_ < NREP(0); ++rep_) {
        { PHASE_WS const float* xin = layer == 0 ? (const float*)a.in[0] : (const float*)a.out; phase0(a, layer, xin, lds, tid, lane, wid); }
        if (layer == 0 && rep_ == 0) cg::this_grid().sync();
        else GSYNC(); }
#endif
#if (PHM >> 1) & 1
_Pragma("unroll 1")
        for (int rep_ = 0; rep_ < NREP(1); ++rep_) {
        { PHASE_WS
        { pg8::Gemm g{H64, (const bf16_t*)(ws + WS_WCAT), MTOK, NCAT, 1024}; pg8::StaticOrder S; S.init(MTOK, NCAT, G, bx);
          pg8::EpiG1 E{(bf16_t*)(ws + WS_QA), (bf16_t*)(ws + WS_KCMP), (bf16_t*)(ws + WS_VCMP), (bf16_t*)(ws + WS_KSLC), (bf16_t*)(ws + WS_VSLC), (bf16_t*)(ws + WS_KWIN), (bf16_t*)(ws + WS_VWIN),
                       (bf16_t*)(ws + WS_QB), (bf16_t*)(ws + WS_KB), (bf16_t*)(ws + WS_VB), (bf16_t*)(ws + WS_U), (bf16_t*)(ws + WS_V), ws + WS_GATES, (float*)(ws + WS_GA),
                       (const float*)a.in[22] + (size_t)layer * 3072, cosT, sinT, C2};
          pg8::gemm_phase<pg8::EpiG1, pg8::StaticOrder, true, true>(lds, g, S, E); }
        }
        GSYNC(); }
#endif
#if (PHM >> 2) & 1
        { PHASE_WS
#ifndef NO_CMPR
_Pragma("unroll 1")
        for (int rep_ = 0; rep_ < NREP(11); ++rep_)
        for (int u = bx; u < 256; u += G) compress_unit(a, u, lds, tid, lane, wid);
#endif
#ifndef NO_SGU
        if (((DBL >> 14) & 1) && layer == 0) for (int u = bx; u < 256; u += G) sgu_unit(a, layer, u, lds, tid, lane, wid, (bf16_t*)a.out);
        for (int u = bx; u < 256; u += G) sgu_unit(a, layer, u, lds, tid, lane, wid, (bf16_t*)(ws + WS_U));
#endif
#ifndef NO_SWA
        { attn_body::AArgs A{}; A.Q = (const attn_body::bf16*)(ws + WS_QA); A.K = (const attn_body::bf16*)(ws + WS_KWIN); A.V = (const attn_body::bf16*)(ws + WS_VWIN); A.O = (attn_body::bf16*)(ws + WS_OWIN);
          A.qp = 512; A.kp = 128; A.vp = 128; A.op = 512; A.cosT = cosT; A.sinT = sinT;
_Pragma("unroll 1")
          for (int rep_ = 0; rep_ < NREP(12); ++rep_)
          for (int u = bx; u < 1024; u += G) { const int xcd = u & 7, j = u >> 3, b = xcd >> 1, h = 4 * (xcd & 1) + (j & 3), qb = j >> 2;
              attn_body::attn_unit<1, 8>(b, h * 64, (h >> 2) * 64, (h >> 2) * 64, h * 64, h, h >> 2, qb, A, (char*)lds_raw); } }
#endif
        }
        GSYNC();
#endif
#if (PHM >> 3) & 1
_Pragma("unroll 1")
        for (int rep_ = 0; rep_ < NREP(3); ++rep_) {
        { PHASE_WS cmp_phase(a, lds, tid, lane, wid); }
        GSYNC(); }
#endif
#if (PHM >> 4) & 1
        { PHASE_WS
        for (int v = bx; v < 256; v += G) {
#ifndef NO_DIFF
            { attn_body::AArgs A{}; A.Q = (const attn_body::bf16*)(ws + WS_QB); A.K = (const attn_body::bf16*)(ws + WS_KB); A.V = (const attn_body::bf16*)(ws + WS_VB); A.O = (attn_body::bf16*)H64;
              A.qp = 512; A.kp = 512; A.vp = 512; A.op = 1024; A.subln = (const float*)a.in[14] + layer * 128; A.ob = (attn_body::bf16*)(ws + WS_QB); A.lamp = (const float*)(ws + WS_LAM);
              const int xcd = v & 7, j = v >> 3, s = j & 15, b = xcd >> 1, hd = 2 * (xcd & 1) + (j >> 4);
#pragma unroll 1
              for (int i = 0; i < 4 * NREP(13); ++i) { const int qb = (i & 2) ? s : 31 - s; const int mp = 2 * hd + (i & 1);
                  attn_body::attn_unit<3, 8>(b, mp * 64, mp * 64, hd * 128, mp * 128, 0, 0, qb, A, (char*)lds_raw, (i & 1) != 0); } }
#endif
#ifndef NO_SLC
            { attn_body::AArgs A{}; A.Q = (const attn_body::bf16*)(ws + WS_QA); A.K = (const attn_body::bf16*)(ws + WS_KSLC); A.V = (const attn_body::bf16*)(ws + WS_VSLC); A.O = (attn_body::bf16*)(ws + WS_QA);
              A.qp = 512; A.kp = 128; A.vp = 128; A.op = 512; A.cosT = cosT; A.sinT = sinT; A.sel = (const attn_body::u32x4*)(ws + WS_SEL);
              A.ocmp = (const attn_body::bf16*)(ws + WS_OCMP); A.owin = (const attn_body::bf16*)(ws + WS_OWIN); A.ga = (const float*)(ws + WS_GA);
              const int xcd = v & 7, j = v >> 3, s = j & 7, b = xcd >> 1, h = 4 * (xcd & 1) + (j >> 3);
              if (((DBL >> 17) & 1) && layer == 0) { attn_body::AArgs B_ = A; B_.O = (attn_body::bf16*)a.out;
#pragma unroll 1
                  for (int i = 0; i < 4; ++i) { const int k = 3 - i; const int qb = (k & 1) ? 16 * (k >> 1) + 15 - s : 16 * (k >> 1) + s;
                      attn_body::attn_unit<0, 8>(b, h * 64, (h >> 2) * 64, (h >> 2) * 64, h * 64, h, h >> 2, qb, B_, (char*)lds_raw); } }
#pragma unroll 1
              for (int i = 0; i < 4 + ((((DBL >> 16) & 1) && layer == 0) ? 4 : 0); ++i) { const int k = 3 - (i & 3); const int qb = (k & 1) ? 16 * (k >> 1) + 15 - s : 16 * (k >> 1) + s;
                  if (((DBL >> 16) & 1) && layer == 0) A.O = (i < 4) ? (attn_body::bf16*)a.out : (attn_body::bf16*)(ws + WS_QA);
                  attn_body::attn_unit<2, 8>(b, h * 64, (h >> 2) * 64, (h >> 2) * 64, h * 64, h, h >> 2, qb, A, (char*)lds_raw); } }
#endif
        }
        }
        GSYNC();
#endif
#if (PHM >> 5) & 1
        { PHASE_WS diff_post(a, layer, lambda_init, tid); }
        GSYNC();
#endif
#if (PHM >> 6) & 1
_Pragma("unroll 1")
        for (int rep_ = 0; rep_ < NREP(6); ++rep_) {
        { PHASE_WS
        { pg8::Gemm g{(const bf16_t*)(ws + WS_QA), (const bf16_t*)(ws + WS_WBR), MTOK, 1024, 512}; pg8::BranchOrder S; S.S.init(MTOK, 1024, G, bx);
          pg8::EpiBranch E{ws + WS_GATES, H64};
          pg8::gemm_phase<pg8::EpiBranch, pg8::BranchOrder, true, true>(lds, g, S, E); }
        }
        GSYNC(); }
#endif
#if (PHM >> 7) & 1
        { PHASE_WS
        { pg8::Gemm g{H64, (const bf16_t*)(ws + WS_WOUT), MTOK, 1024, 1024}; pg8::StaticOrder S; S.init(MTOK, 1024, G, bx);
          const float* xin = layer == 0 ? (const float*)a.in[0] : (const float*)a.out; pg8::EpiResid E{xin, a.out};
          pg8::gemm_phase<pg8::EpiResid, pg8::StaticOrder, true, true>(lds, g, S, E); }
        }
        GSYNC();
#endif
#if (PHM >> 8) & 1
_Pragma("unroll 1")
        for (int rep_ = 0; rep_ < NREP(8); ++rep_) {
        { PHASE_WS
        rms_rows_bf16(a.out, (const float*)a.in[24] + (size_t)layer * DMODEL, H64, bx * 8 + wid, G * 8, lane);
        }
        GSYNC(); }
#endif
#if (PHM >> 9) & 1
_Pragma("unroll 1")
        for (int rep_ = 0; rep_ < NREP(9); ++rep_) {
        { PHASE_WS
        { pg8::Gemm g{H64, (const bf16_t*)(ws + WS_W13), MTOK, NFF13, 1024}; pg8::StaticOrder S; S.init(MTOK, NFF13, G, bx);
          pg8::EpiSwiGLU E{(bf16_t*)(ws + WS_HID)};
          pg8::gemm_phase<pg8::EpiSwiGLU, pg8::StaticOrder, true, true>(lds, g, S, E); }
        }
        GSYNC(); }
#endif
#if (PHM >> 10) & 1
        { PHASE_WS
        { pg8::Gemm g{(const bf16_t*)(ws + WS_HID), (const bf16_t*)(ws + WS_W2), MTOK, 1024, DFF}; pg8::StaticOrder S; S.init(MTOK, 1024, G, bx);
          pg8::EpiResid E{a.out, a.out};
          pg8::gemm_phase<pg8::EpiResid, pg8::StaticOrder, true, true>(lds, g, S, E); }
        }
        GSYNC();
#endif
}

__global__ void __launch_bounds__(512, 2) fwd_kernel(KArgs kargs_) {
    extern __shared__ __attribute__((aligned(16))) unsigned char lds_raw[];
    LAS unsigned char* lds = (LAS unsigned char*)lds_raw;
    cg::grid_group grid = cg::this_grid();
    const int tid = threadIdx.x, lane = tid & 63, wid = __builtin_amdgcn_readfirstlane(tid >> 6);
    const int G = gridDim.x, bx = blockIdx.x;
    if (tid < 2) ((LAS unsigned*)(lds + LDS_BARW))[tid] = 0u;
    __syncthreads();
    XcdBarrier bar;
    { PHASE_WS bar = xcd_barrier_post((unsigned*)(ws + WS_BAR), (volatile LAS unsigned*)(lds + LDS_BARW)); rope_table(a, tid); }
    run_layer<0>(lds, lds_raw, bar, tid, lane, wid, G, bx);
    run_layer<1>(lds, lds_raw, bar, tid, lane, wid, G, bx);
    { PHASE_WS rms_rows_f32(a.out, (const float*)a.in[28], bx * 8 + wid, G * 8, lane); }
}

extern "C" void kernel_launch(void* const* d_in, const int* in_sizes, int n_in, void* d_out, int out_size, void* d_ws, size_t ws_size, hipStream_t stream) {
    static int grid = 0;
    if (grid == 0) {
        if (n_in != 29 || out_size != MTOK * DMODEL || ws_size < WS_END) { fprintf(stderr, "kernel_launch: unexpected shapes (n_in %d out %d ws %zu)\n", n_in, out_size, ws_size); grid = -1; return; }
        int dev = 0, cus = 0, per_cu = 0;
        hipGetDevice(&dev); hipDeviceGetAttribute(&cus, hipDeviceAttributeMultiprocessorCount, dev);
        if (hipFuncSetAttribute((const void*)fwd_kernel, hipFuncAttributeMaxDynamicSharedMemorySize, LDS_BYTES) != hipSuccess) { fprintf(stderr, "kernel_launch: hipFuncSetAttribute failed\n"); grid = -1; return; }
        if (hipOccupancyMaxActiveBlocksPerMultiprocessor(&per_cu, (const void*)fwd_kernel, 512, LDS_BYTES) != hipSuccess || per_cu < 1) { fprintf(stderr, "kernel_launch: occupancy query gave %d\n", per_cu); per_cu = 1; }
        (void)hipGetLastError();
        grid = cus * 1;
        if (grid > 256) grid = 256;
    }
    if (grid < 0) return;
    if (hipMemsetAsync((char*)d_ws + WS_BAR, 0, WS_BAR_BYTES, stream) != hipSuccess) { fprintf(stderr, "kernel_launch: memset failed\n"); return; }
    KArgs a{};
    for (int i = 0; i < 29; ++i) a.in[i] = d_in[i];
    a.out = (float*)d_out; a.ws = (unsigned char*)d_ws;
    void* args[] = {&a};
    hipError_t e = hipLaunchCooperativeKernel((const void*)fwd_kernel, dim3(grid), dim3(512), args, LDS_BYTES, stream);
    if (e != hipSuccess) fprintf(stderr, "cooperative launch failed: %s (grid %d)\n", hipGetErrorString(e), grid);
}
```

```cpp
#include <hip/hip_runtime.h>
#include <hip/hip_cooperative_groups.h>
#include <hip/hip_bf16.h>
#include <cstdio>
#include <cstdint>
#include <cmath>
namespace cg = cooperative_groups;
namespace pg8 {
#define PG8_LAS __attribute__((address_space(3)))
typedef unsigned short bf16_t;
typedef short bf16x8 __attribute__((ext_vector_type(8)));
typedef float f32x4 __attribute__((ext_vector_type(4)));
typedef unsigned u32x4 __attribute__((ext_vector_type(4)));
constexpr int BM = 256, BK = 64, HALF = 128, HTB = HALF * BK * 2  , STAGE_BYTES = 8 * HTB, NXCD = 8, WGM = 8;

__host__ __device__ __forceinline__ int lds_byte(int r, int c) { const int st = (r >> 4) * 2 + (c >> 5), rr = r & 15, cc = c & 31, ob = rr * 64 + cc * 2; return st * 1024 + (ob ^ (((ob >> 9) & 1) << 5)); }
__host__ __device__ __forceinline__ void stage_rc(int b, int& R, int& C) { const int st = b / 1024, sb = b % 1024, swz = sb ^ (((sb >> 9) & 1) << 5); R = (st >> 1) * 16 + swz / 64; C = (st & 1) * 32 + (swz % 64) / 2; }
__host__ __device__ __forceinline__ int perm32(int rho) { const int n = rho >> 4, i = rho & 15; return 8 * (i >> 2) + 4 * n + (i & 3); }

struct Unit { int pm, pn; };
struct Gemm { const bf16_t* A; const bf16_t* Bt; int M, N, K; };

struct StaticOrder {
    int nM, nN, nwg, G, c;
    __host__ __device__ void init(int M, int N, int G_, int c_) { nM = M / BM; nN = N / BM; nwg = nM * nN; G = G_; c = c_; }
    __host__ __device__ bool next(int i, Unit& u) const {
        const long L = (long)i * G + c; if (L >= nwg) return false;
        int wgid = (int)L; { const int q = nwg / NXCD, r = nwg % NXCD, xcd = wgid % NXCD, off = wgid / NXCD; wgid = (xcd < r ? xcd * (q + 1) : r * (q + 1) + (xcd - r) * q) + off; }
        const int nig = WGM * nN, gid = wgid / nig, fm = gid * WGM, gsz = (nM - fm) < WGM ? (nM - fm) : WGM;
        u.pm = fm + ((wgid % nig) % gsz); u.pn = (wgid % nig) / gsz; return true;
    }
    __device__ __forceinline__ void a_ready(const Unit&) const {}
    __device__ __forceinline__ void done(const Unit&) const {}
};

__device__ __forceinline__ unsigned cvt_pk_bf16(float lo, float hi) { unsigned r; asm volatile("v_cvt_pk_bf16_f32 %0, %1, %2" : "=v"(r) : "v"(lo), "v"(hi)); return r; }
typedef unsigned u32x2 __attribute__((ext_vector_type(2)));
__device__ __forceinline__ float bf_lo(unsigned w) { return __uint_as_float(w << 16); }
__device__ __forceinline__ float bf_hi(unsigned w) { return __uint_as_float(w & 0xffff0000u); }
__device__ __forceinline__ float fast_sigmoid(float x) { return __builtin_amdgcn_rcpf(1.0f + __builtin_amdgcn_exp2f(-1.4426950408889634f * x)); }
__device__ __forceinline__ float gelu_tanh(float x) { const float z = 0.7978845608028654f * (x + 0.044715f * x * x * x); return x * __builtin_amdgcn_rcpf(1.0f + __builtin_amdgcn_exp2f(-2.885390081777927f * z)); }
__device__ __forceinline__ u32x4 pack8(const f32x4& a, const f32x4& b) { u32x4 w; w.x = cvt_pk_bf16(a[0], a[1]); w.y = cvt_pk_bf16(a[2], a[3]); w.z = cvt_pk_bf16(b[0], b[1]); w.w = cvt_pk_bf16(b[2], b[3]); return w; }

struct EpiG1 {
    static constexpr bool PERM = true, AFTER_DRAIN = false, KEEPS = false;
    bf16_t *qa, *kcmp, *vcmp, *kslc, *vslc, *kwin, *vwin, *qb, *kb, *vb, *uu, *vv; unsigned char* gates; float* ga;
    const float* bmerge; const float* cosT; const float* sinT; float c2;
    __device__ __forceinline__ void operator()(const f32x4 (&acc)[2][2][4][2], const Unit& u, int wr, int wc, int fr, int fq) const {
        const int pn = u.pn; const int row0 = u.pm * BM + wr * 64 + fr; const int lc = wc * 32 + 8 * fq;
#pragma unroll
        for (int bj = 0; bj < 2; ++bj) {
            int mode = 0; bf16_t* dst = qa; int pitch = 512, colb = 0; float sc = 1.f;
            if (pn < 2) { dst = qa; colb = pn * 256 + bj * 128; sc = c2; }
            else if (pn == 2) { dst = bj ? vcmp : kcmp; pitch = 128; }
            else if (pn == 3) { dst = bj ? vslc : kslc; pitch = 128; mode = bj ? 0 : 1; }
            else if (pn == 4) { dst = bj ? vwin : kwin; pitch = 128; mode = bj ? 0 : 1; }
            else if (pn < 7) { dst = qb; colb = (pn - 5) * 256 + bj * 128; sc = c2; mode = 1; }
            else if (pn < 9) { dst = kb; colb = (pn - 7) * 256 + bj * 128; mode = 1; }
            else if (pn < 11) { dst = vb; colb = (pn - 9) * 256 + bj * 128; }
            else if (pn < 13) { dst = uu; colb = (pn - 11) * 256 + bj * 128; mode = 2; }
            else if (pn < 15) { dst = vv; colb = (pn - 13) * 256 + bj * 128; mode = 2; }
            else if (pn < 27) { colb = (pn - 15) * 256 + bj * 128; mode = 3; }
            else mode = 4;
            const int col = colb + lc;
            if (mode == 0) {
#pragma unroll
                for (int ai = 0; ai < 2; ++ai)
#pragma unroll
                    for (int m = 0; m < 4; ++m) { const int row = row0 + ai * HALF + m * 16;
                        *(u32x4*)(dst + (size_t)row * pitch + col) = pack8(acc[ai][bj][m][0] * sc, acc[ai][bj][m][1] * sc); }
            } else if (mode == 1) {
                const int g8 = (lc & 63) >> 3;
#pragma unroll
                for (int ai = 0; ai < 2; ++ai)
#pragma unroll
                    for (int m = 0; m < 4; ++m) { const int row = row0 + ai * HALF + m * 16;
                        const f32x4 c = *(const f32x4*)(cosT + (size_t)row * 32 + 4 * g8), s = *(const f32x4*)(sinT + (size_t)row * 32 + 4 * g8);
                        const f32x4 x1 = acc[ai][bj][m][0], x2 = acc[ai][bj][m][1];
                        const f32x4 y1 = (x1 * c - x2 * s) * sc, y2 = (x2 * c + x1 * s) * sc;
                        *(u32x4*)(dst + (size_t)row * pitch + col) = pack8(y1, y2); }
            } else if (mode == 2) {
#pragma unroll
                for (int ai = 0; ai < 2; ++ai)
#pragma unroll
                    for (int m = 0; m < 4; ++m) { const int row = row0 + ai * HALF + m * 16; f32x4 a = acc[ai][bj][m][0], b = acc[ai][bj][m][1];
#pragma unroll
                        for (int k = 0; k < 4; ++k) { a[k] = gelu_tanh(a[k]); b[k] = gelu_tanh(b[k]); }
                        *(u32x4*)(dst + (size_t)row * pitch + col) = pack8(a, b); }
            } else if (mode == 3) {
                const f32x4 b0 = *(const f32x4*)(bmerge + col), b1 = *(const f32x4*)(bmerge + col + 4);
#pragma unroll
                for (int ai = 0; ai < 2; ++ai)
#pragma unroll
                    for (int m = 0; m < 4; ++m) { const int row = row0 + ai * HALF + m * 16; const f32x4 a = acc[ai][bj][m][0] + b0, b = acc[ai][bj][m][1] + b1;
                        unsigned lo = 0u, hi = 0u;
#pragma unroll
                        for (int k = 0; k < 4; ++k) { const unsigned qa_ = (unsigned)(fast_sigmoid(a[k]) * 256.0f), qb_ = (unsigned)(fast_sigmoid(b[k]) * 256.0f); lo |= (qa_ > 255u ? 255u : qa_) << (8 * k); hi |= (qb_ > 255u ? 255u : qb_) << (8 * k); }
                        *(u32x2*)(gates + (size_t)row * 3072 + col) = (u32x2){lo, hi}; }
            } else {
                if (bj == 0 && lc < 24) {
#pragma unroll
                    for (int ai = 0; ai < 2; ++ai)
#pragma unroll
                        for (int m = 0; m < 4; ++m) { const int row = row0 + ai * HALF + m * 16; f32x4 a = acc[ai][bj][m][0], b = acc[ai][bj][m][1];
#pragma unroll
                            for (int k = 0; k < 4; ++k) { a[k] = fast_sigmoid(a[k]); b[k] = fast_sigmoid(b[k]); }
                            *(f32x4*)(ga + (size_t)row * 24 + lc) = a; *(f32x4*)(ga + (size_t)row * 24 + lc + 4) = b; }
                }
            }
        }
    }
};
struct BranchOrder {
    StaticOrder S;
    __device__ __forceinline__ bool next(int i, Unit& u) const { Unit t; const int r = i / 3, b = i - 3 * r; if (!S.next(r, t)) return false; u.pm = t.pm + (b == 0 ? 0 : b == 1 ? 320 : 704); u.pn = t.pn + 4 * b; return true; }
    __device__ __forceinline__ void a_ready(const Unit&) const {}
    __device__ __forceinline__ void done(const Unit&) const {}
};
struct EpiBranch {
    static constexpr bool PERM = true, AFTER_DRAIN = false, KEEPS = true;
    const unsigned char* gates; bf16_t* mixed;
    __device__ __forceinline__ bool keep(const Unit& u) const { return (u.pn >> 2) < 2; }
    __device__ __forceinline__ void run(f32x4 (&acc)[2][2][4][2], const Unit& uu_, int wr, int wc, int fr, int fq) const {
        const int b = uu_.pn >> 2; Unit u; u.pn = uu_.pn & 3; u.pm = uu_.pm - (b == 0 ? 0 : b == 1 ? 320 : 704);
        const int row0 = u.pm * BM + wr * 64 + fr;
#pragma unroll
        for (int bj = 0; bj < 2; ++bj) { const int col = u.pn * BM + bj * HALF + wc * 32 + 8 * fq;
#pragma unroll
            for (int ai = 0; ai < 2; ++ai)
#pragma unroll
                for (int m = 0; m < 4; ++m) { const int row = row0 + ai * HALF + m * 16;
                    const u32x2 gq = *(const u32x2*)(gates + (size_t)row * 3072 + b * 1024 + col);
                    f32x4 g0, g1;
#pragma unroll
                    for (int k = 0; k < 4; ++k) { g0[k] = ((float)((gq.x >> (8 * k)) & 255u) + 0.5f) * (1.0f / 256.0f); g1[k] = ((float)((gq.y >> (8 * k)) & 255u) + 0.5f) * (1.0f / 256.0f); }
                    if (b < 2) { const u32x2 gn = *(const u32x2*)(gates + (size_t)row * 3072 + (b + 1) * 1024 + col);
#pragma unroll
                        for (int k = 0; k < 4; ++k) { g0[k] *= __builtin_amdgcn_rcpf(((float)((gn.x >> (8 * k)) & 255u) + 0.5f) * (1.0f / 256.0f)); g1[k] *= __builtin_amdgcn_rcpf(((float)((gn.y >> (8 * k)) & 255u) + 0.5f) * (1.0f / 256.0f)); }
                        acc[ai][bj][m][0] *= g0; acc[ai][bj][m][1] *= g1; }
                    else *(u32x4*)(mixed + (size_t)row * 1024 + col) = pack8(acc[ai][bj][m][0] * g0, acc[ai][bj][m][1] * g1); }
        }
    }
};
struct EpiResid {
    static constexpr bool PERM = true, AFTER_DRAIN = false, KEEPS = false;
    const float* xin; float* xout;
    __device__ __forceinline__ void operator()(const f32x4 (&acc)[2][2][4][2], const Unit& u, int wr, int wc, int fr, int fq) const {
        const int row0 = u.pm * BM + wr * 64 + fr;
#pragma unroll
        for (int bj = 0; bj < 2; ++bj) { const int col = u.pn * BM + bj * HALF + wc * 32 + 8 * fq;
#pragma unroll
            for (int ai = 0; ai < 2; ++ai)
#pragma unroll
                for (int m = 0; m < 4; ++m) { const size_t off = (size_t)(row0 + ai * HALF + m * 16) * 1024 + col;
                    const f32x4 a = *(const f32x4*)(xin + off), b = *(const f32x4*)(xin + off + 4);
                    *(f32x4*)(xout + off) = a + acc[ai][bj][m][0]; *(f32x4*)(xout + off + 4) = b + acc[ai][bj][m][1]; }
        }
    }
};
struct EpiSwiGLU {
    static constexpr bool PERM = true, AFTER_DRAIN = false, KEEPS = false;
    bf16_t* hid;
    __device__ __forceinline__ void operator()(const f32x4 (&acc)[2][2][4][2], const Unit& u, int wr, int wc, int fr, int fq) const {
        const int row0 = u.pm * BM + wr * 64 + fr; const int col = u.pn * HALF + wc * 32 + 8 * fq;
#pragma unroll
        for (int ai = 0; ai < 2; ++ai)
#pragma unroll
            for (int m = 0; m < 4; ++m) { const int row = row0 + ai * HALF + m * 16; f32x4 a = acc[ai][0][m][0], b = acc[ai][0][m][1];
#pragma unroll
                for (int k = 0; k < 4; ++k) { a[k] = a[k] * fast_sigmoid(a[k]) * acc[ai][1][m][0][k]; b[k] = b[k] * fast_sigmoid(b[k]) * acc[ai][1][m][1][k]; }
                *(u32x4*)(hid + (size_t)row * 2816 + col) = pack8(a, b); }
    }
};
template <class Epi, class Sched, bool ALIGN_EPI = false, bool SP2 = false>
__device__ __forceinline__ void gemm_phase(PG8_LAS unsigned char* lds, const Gemm g, const Sched& S, const Epi& E) {
    int tid_ = threadIdx.x; asm volatile("" : "+v"(tid_)); const int tid = tid_, wid = __builtin_amdgcn_readfirstlane(tid >> 6), lane = tid & 63, wr = wid >> 2, wc = wid & 3, fr = lane & 15, fq = lane >> 4;
    const int K = g.K, nt = K / BK;
    unsigned voffA[2], voffB[2];
#pragma unroll
    for (int i = 0; i < 2; ++i) { int R, C; stage_rc(tid * 16 + i * 8192, R, C); const int Rb = Epi::PERM ? ((R & ~31) + perm32(R & 31)) : R;
        voffA[i] = (unsigned)(R * K + C) * 2u; voffB[i] = (unsigned)(Rb * K + C) * 2u; }
    const size_t kstep = (size_t)(BK * 2);
    const size_t hstep = (size_t)HALF * K * 2;
    const size_t tstep = 2 * hstep;
    const unsigned ldsw = (unsigned)wid * 1024u;
    const int aoff = lds_byte(wr * 64 + fr, fq * 8), boff = lds_byte(wc * 32 + fr, fq * 8);
#define PG8_SA(b, h) (((b) * 2 + (h)) * HTB)
#define PG8_SB(b, h) ((4 + (b) * 2 + (h)) * HTB)
#define PG8_STAGE(bufoff, gbase, voff) do { _Pragma("unroll") for (int _i = 0; _i < 2; ++_i) \
        __builtin_amdgcn_global_load_lds((const unsigned*)((const char*)(gbase) + (voff)[_i]), (PG8_LAS unsigned*)(lds + (bufoff) + ldsw + _i * 8192), 16, 0, 0); } while (0)
#define PG8_LDA(dst, b, h) do { _Pragma("unroll") for (int m = 0; m < 4; ++m) _Pragma("unroll") for (int k = 0; k < 2; ++k) dst[m][k] = *(const PG8_LAS bf16x8*)(lds + PG8_SA(b, h) + aoff + m * 2048 + k * 1024); } while (0)
#define PG8_LDB(dst, b, h) do { _Pragma("unroll") for (int n = 0; n < 2; ++n) _Pragma("unroll") for (int k = 0; k < 2; ++k) dst[n][k] = *(const PG8_LAS bf16x8*)(lds + PG8_SB(b, h) + boff + n * 2048 + k * 1024); } while (0)
#define PG8_MMA(ai, bj, At, Bt) do { __builtin_amdgcn_s_setprio(1); _Pragma("unroll") for (int m = 0; m < 4; ++m) _Pragma("unroll") for (int n = 0; n < 2; ++n) _Pragma("unroll") for (int k = 0; k < 2; ++k) \
        acc[ai][bj][m][n] = __builtin_amdgcn_mfma_f32_16x16x32_bf16(Bt[n][k], At[m][k], acc[ai][bj][m][n], 0, 0, 0); __builtin_amdgcn_s_setprio(0); } while (0)
#define PG8_WAIT_V(n) asm volatile("s_waitcnt vmcnt(" #n ")" ::: "memory")
#define PG8_WAIT_L(n) asm volatile("s_waitcnt lgkmcnt(" #n ")" ::: "memory")
#define PG8_BAR __builtin_amdgcn_s_barrier()
#define PG8_SCHED __builtin_amdgcn_sched_barrier(0)
    Unit cur, nxt; int ui = 0;
    if (!S.next(0, cur)) return;
    f32x4 acc[2][2][4][2];
#pragma unroll
    for (int a = 0; a < 2; ++a)
#pragma unroll
        for (int b = 0; b < 2; ++b)
#pragma unroll
            for (int m = 0; m < 4; ++m)
#pragma unroll
                for (int n = 0; n < 2; ++n) acc[a][b][m][n] = (f32x4){0.f, 0.f, 0.f, 0.f};
    bf16x8 At[4][2], B0[2][2], B1[2][2];
    const char* cA = (const char*)g.A + (size_t)cur.pm * tstep; const char* cB = (const char*)g.Bt + (size_t)cur.pn * tstep;
    S.a_ready(cur);
    if constexpr (SP2) {
        PG8_STAGE(PG8_SB(0, 0), cB, voffB); PG8_STAGE(PG8_SB(0, 1), cB + hstep, voffB); PG8_STAGE(PG8_SA(0, 0), cA, voffA); PG8_STAGE(PG8_SA(0, 1), cA + hstep, voffA);
        if (wr == 1) PG8_BAR;
        PG8_WAIT_V(2); PG8_BAR;
        PG8_STAGE(PG8_SB(1, 0), cB + kstep, voffB); PG8_STAGE(PG8_SA(1, 0), cA + kstep, voffA); PG8_STAGE(PG8_SB(1, 1), cB + hstep + kstep, voffB);
        PG8_WAIT_V(6); PG8_BAR;
    } else {
        PG8_STAGE(PG8_SB(0, 0), cB, voffB); PG8_STAGE(PG8_SA(0, 0), cA, voffA); PG8_STAGE(PG8_SB(0, 1), cB + hstep, voffB); PG8_STAGE(PG8_SA(0, 1), cA + hstep, voffA);
        if (wr == 1) PG8_BAR;
        PG8_WAIT_V(4); PG8_BAR;
        PG8_STAGE(PG8_SB(1, 0), cB + kstep, voffB); PG8_STAGE(PG8_SA(1, 0), cA + kstep, voffA); PG8_STAGE(PG8_SB(1, 1), cB + hstep + kstep, voffB);
        PG8_WAIT_V(6); PG8_BAR;
    }
    for (;;) {
        const bool has_next = S.next(ui + 1, nxt);
        const char* nA = has_next ? (const char*)g.A + (size_t)nxt.pm * tstep : cA; const char* nB = has_next ? (const char*)g.Bt + (size_t)nxt.pn * tstep : cB;
        for (int t = 0; t < nt; t += 2) {
            const bool last = (t == nt - 2);
            const char* a1 = cA + (size_t)(t + 1) * kstep;
            const char* a2 = last ? nA : cA + (size_t)(t + 2) * kstep; const char* b2 = last ? nB : cB + (size_t)(t + 2) * kstep;
            const char* a3 = a2 + kstep; const char* b3 = b2 + kstep;
            if (last && has_next) S.a_ready(nxt);
            if constexpr (SP2) {
            PG8_LDB(B0, 0, 0); PG8_LDB(B1, 0, 1); PG8_SCHED; PG8_LDA(At, 0, 0); PG8_STAGE(PG8_SA(1, 1), a1 + hstep, voffA);
            PG8_WAIT_V(8); PG8_WAIT_L(0); PG8_BAR; PG8_MMA(0, 0, At, B0); PG8_MMA(0, 1, At, B1); PG8_BAR; PG8_SCHED;
            PG8_LDA(At, 0, 1); PG8_STAGE(PG8_SB(0, 0), b2, voffB); PG8_STAGE(PG8_SB(0, 1), b2 + hstep, voffB); PG8_STAGE(PG8_SA(0, 0), a2, voffA);
            PG8_WAIT_V(8); PG8_WAIT_L(0); PG8_BAR; PG8_MMA(1, 0, At, B0); PG8_MMA(1, 1, At, B1); PG8_BAR; PG8_SCHED;
            PG8_LDB(B0, 1, 0); PG8_LDB(B1, 1, 1); PG8_SCHED; PG8_LDA(At, 1, 0); PG8_STAGE(PG8_SA(0, 1), a2 + hstep, voffA);
            PG8_WAIT_V(8); PG8_WAIT_L(0); PG8_BAR; PG8_MMA(0, 0, At, B0); PG8_MMA(0, 1, At, B1); PG8_BAR; PG8_SCHED;
            PG8_LDA(At, 1, 1); PG8_STAGE(PG8_SB(1, 0), b3, voffB); PG8_STAGE(PG8_SB(1, 1), b3 + hstep, voffB); PG8_STAGE(PG8_SA(1, 0), a3, voffA);
            PG8_WAIT_V(8); PG8_WAIT_L(0); PG8_BAR; PG8_MMA(1, 0, At, B0); PG8_MMA(1, 1, At, B1); PG8_BAR; PG8_SCHED;
            } else {
            PG8_LDB(B0, 0, 0); PG8_SCHED; PG8_LDA(At, 0, 0); PG8_STAGE(PG8_SA(1, 1), a1 + hstep, voffA);
            PG8_WAIT_L(8); PG8_BAR; PG8_WAIT_L(0); PG8_MMA(0, 0, At, B0); PG8_BAR; PG8_SCHED;
            PG8_LDB(B1, 0, 1); PG8_STAGE(PG8_SB(0, 0), b2, voffB);
            PG8_BAR; PG8_WAIT_L(0); PG8_MMA(0, 1, At, B1); PG8_BAR;
            PG8_LDA(At, 0, 1); PG8_STAGE(PG8_SA(0, 0), a2, voffA);
            PG8_BAR; PG8_WAIT_L(0); PG8_MMA(1, 0, At, B0); PG8_BAR; PG8_SCHED;
            PG8_STAGE(PG8_SB(0, 1), b2 + hstep, voffB);
            PG8_WAIT_V(6); PG8_BAR; PG8_MMA(1, 1, At, B1); PG8_BAR;
            PG8_LDB(B0, 1, 0); PG8_SCHED; PG8_LDA(At, 1, 0); PG8_STAGE(PG8_SA(0, 1), a2 + hstep, voffA);
            PG8_WAIT_L(8); PG8_BAR; PG8_WAIT_L(0); PG8_MMA(0, 0, At, B0); PG8_BAR; PG8_SCHED;
            PG8_LDB(B1, 1, 1); PG8_STAGE(PG8_SB(1, 0), b3, voffB);
            PG8_BAR; PG8_WAIT_L(0); PG8_MMA(0, 1, At, B1); PG8_BAR;
            PG8_LDA(At, 1, 1); PG8_STAGE(PG8_SA(1, 0), a3, voffA);
            PG8_BAR; PG8_WAIT_L(0); PG8_MMA(1, 0, At, B0); PG8_BAR; PG8_SCHED;
            PG8_STAGE(PG8_SB(1, 1), b3 + hstep, voffB);
            PG8_WAIT_V(6); PG8_BAR; PG8_MMA(1, 1, At, B1); PG8_BAR;
            }
        }
        if constexpr (ALIGN_EPI) { if (wr == 0) PG8_BAR; }
        bool keep_acc = false;
        if constexpr (Epi::KEEPS) { E.run(acc, cur, wr, wc, fr, fq); keep_acc = E.keep(cur); }
        else if constexpr (!Epi::AFTER_DRAIN) { E(acc, cur, wr, wc, fr, fq); S.done(cur); }
        if (!has_next) break;
        if (!keep_acc)
#pragma unroll
        for (int a = 0; a < 2; ++a)
#pragma unroll
            for (int b = 0; b < 2; ++b)
#pragma unroll
                for (int m = 0; m < 4; ++m)
#pragma unroll
                    for (int n = 0; n < 2; ++n) acc[a][b][m][n] = (f32x4){0.f, 0.f, 0.f, 0.f};
        cur = nxt; cA = nA; cB = nB; ++ui;
        if constexpr (ALIGN_EPI) { if (wr == 1) PG8_BAR; }
    }
    PG8_WAIT_V(0);
    if constexpr (!ALIGN_EPI) { if (wr == 0) PG8_BAR; }
    PG8_BAR;
    if constexpr (Epi::AFTER_DRAIN) { E.fused(acc, cur, wr, wc, fr, fq, lds, wid, lane); S.done(cur); }
#undef PG8_SA
#undef PG8_SB
#undef PG8_STAGE
#undef PG8_LDA
#undef PG8_LDB
#undef PG8_MMA
#undef PG8_WAIT_V
#undef PG8_WAIT_L
#undef PG8_BAR
#undef PG8_SCHED
}
}
namespace attn_body {
using bf16=__hip_bfloat16;
using bf16x8=__attribute__((ext_vector_type(8)))short;
using s16x4=__attribute__((ext_vector_type(4)))short;
using f32x16=__attribute__((ext_vector_type(16)))float;
using u32x4=__attribute__((ext_vector_type(4)))unsigned;
constexpr int SEQ=8192,D=64;
constexpr int NW=8,QBLK=32,QB=QBLK*NW,KVBLK=64,NQB=SEQ/QB;
__device__ __forceinline__ int crow(int r,int hi){return (r&3)+8*(r>>2)+4*hi;}
#define SBAR() __builtin_amdgcn_sched_barrier(0)
__device__ __forceinline__ void cmask(f32x16&p0,f32x16&p1,int jb,int qrel,int hi){
  const float NEG=-INFINITY; int kb=64*jb+4*hi;
  const int lim=qrel-kb;
  #pragma unroll
  for(int r=0;r<16;++r){const int c=(r&3)+8*(r>>2); if(c>lim)p0[r]=NEG; if(c+32>lim)p1[r]=NEG;}
}

template<int MODE,bool FULLSEL=true> __device__ __forceinline__ void tmask(f32x16&p0,f32x16&p1,int t,int NT,int qrel,int hi,const u32x4&sel){
  const float NEG=-INFINITY; const int jb=t-(NT-4);
  if(jb>=0)cmask(p0,p1,jb,qrel,hi);
  if(MODE==1){ if(jb<-4){ const int lim=qrel-(64*jb+4*hi+511);
    #pragma unroll
    for(int r=0;r<16;++r){const int c=(r&3)+8*(r>>2); if(c<lim)p0[r]=NEG; if(c+32<lim)p1[r]=NEG;} } }
  if(MODE==2&&FULLSEL){ const unsigned w=(t<32)?sel[0]:(t<64)?sel[1]:(t<96)?sel[2]:sel[3]; const bool on=((w>>(t&31))&1u)!=0u;
    if(!on){
    #pragma unroll
    for(int r=0;r<16;++r){p0[r]=NEG;p1[r]=NEG;} } }
}
struct AArgs { const bf16*Q; const bf16*K; const bf16*V; bf16*O; int qp,kp,vp,op; const float*cosT; const float*sinT; const u32x4*sel; const bf16*ocmp; const bf16*owin; const float*ga; const float*subln; bf16*ob; const float*lamp; };
__device__ __forceinline__ float bf2f(short s){return __uint_as_float(((unsigned)(unsigned short)s)<<16);}
constexpr int NSLOT=3, SLOTB=8192;
constexpr int LDS_K=0, LDS_V=NSLOT*SLOTB, LDS_WS=2*NSLOT*SLOTB, LDS_OST=LDS_WS+NW*64*4, LDS_BYTES=LDS_OST+NW*4096;
constexpr float C2=0.125f*1.4426950408889634f;
__device__ __forceinline__ void glds16(const void*gsrc,unsigned lds_dst){unsigned keep;
  asm volatile("s_mov_b32 %0, m0\n\ts_mov_b32 m0, %2\n\ts_nop 0\n\tglobal_load_lds_dwordx4 %1, off\n\ts_mov_b32 m0, %0":"=&s"(keep):"v"(gsrc),"s"(lds_dst):"memory");}
__device__ __forceinline__ float max3f(float a,float b,float c){float r;asm("v_max3_f32 %0, %1, %2, %3":"=v"(r):"v"(a),"v"(b),"v"(c));return r;}
__device__ __forceinline__ float max2f(float a,float b){float r;asm("v_max_f32_e32 %0, %1, %2":"=v"(r):"v"(a),"v"(b));return r;}
__device__ __forceinline__ float fadd_s(float a,float b){float r;asm("v_add_f32_e32 %0, %1, %2":"=v"(r):"v"(a),"v"(b));return r;}
__device__ __forceinline__ float fsub_s(float a,float b){float r;asm("v_sub_f32_e32 %0, %1, %2":"=v"(r):"v"(a),"v"(b));return r;}
typedef float f32x2_t __attribute__((ext_vector_type(2))); typedef float f32x4_t __attribute__((ext_vector_type(4))); typedef __bf16 bf16x2_t __attribute__((ext_vector_type(2)));
__device__ __forceinline__ unsigned cvtpk_s(float lo,float hi){f32x2_t v={lo,hi};bf16x2_t b=__builtin_convertvector(v,bf16x2_t);return __builtin_bit_cast(unsigned,b);}
#define WAIT_BAR(N) asm volatile("s_waitcnt vmcnt(" #N ") lgkmcnt(0)\n\ts_barrier":::"memory")

__device__ __forceinline__ void qkt(f32x16&p0,f32x16&p1,const char*Kslot,const bf16x8*qr,const f32x16&negm,int r32,int hi){
  const char*kb=Kslot+hi*1024+r32*16;
  #pragma unroll
  for(int d0=0;d0<4;++d0){
    const bf16x8 b0=*reinterpret_cast<const bf16x8*>(kb+d0*2048);
    const bf16x8 b1=*reinterpret_cast<const bf16x8*>(kb+d0*2048+512);
    if(d0==0){p0=__builtin_amdgcn_mfma_f32_32x32x16_bf16(b0,qr[0],negm,0,0,0);p1=__builtin_amdgcn_mfma_f32_32x32x16_bf16(b1,qr[0],negm,0,0,0);}
    else{p0=__builtin_amdgcn_mfma_f32_32x32x16_bf16(b0,qr[d0],p0,0,0,0);p1=__builtin_amdgcn_mfma_f32_32x32x16_bf16(b1,qr[d0],p1,0,0,0);}}
}
typedef __attribute__((address_space(3))) const char* lds_cptr;
typedef short v4i16_t __attribute__((ext_vector_type(4)));
__device__ __forceinline__ void kload8(bf16x8*kf,lds_cptr kp){
  kf[0]=*(const __attribute__((address_space(3))) bf16x8*)(kp);      kf[1]=*(const __attribute__((address_space(3))) bf16x8*)(kp+512);
  kf[2]=*(const __attribute__((address_space(3))) bf16x8*)(kp+2048); kf[3]=*(const __attribute__((address_space(3))) bf16x8*)(kp+2560);
  kf[4]=*(const __attribute__((address_space(3))) bf16x8*)(kp+4096); kf[5]=*(const __attribute__((address_space(3))) bf16x8*)(kp+4608);
  kf[6]=*(const __attribute__((address_space(3))) bf16x8*)(kp+6144); kf[7]=*(const __attribute__((address_space(3))) bf16x8*)(kp+6656);
}
__device__ __forceinline__ void kload2(bf16x8*kf,lds_cptr kp,int j){ kf[2*j]=*(const __attribute__((address_space(3))) bf16x8*)(kp+j*2048); kf[2*j+1]=*(const __attribute__((address_space(3))) bf16x8*)(kp+j*2048+512); }
__device__ __forceinline__ s16x4 vtr(lds_cptr p){ return __builtin_bit_cast(s16x4,__builtin_amdgcn_ds_read_tr16_b64_v4i16((__attribute__((address_space(3))) v4i16_t*)p)); }
__device__ __forceinline__ float rowmax(const f32x16&p0,const f32x16&p1){
  float a=max3f(p0[0],p0[1],p1[0]),b=max3f(p0[2],p0[3],p1[1]);a=max3f(a,p1[2],p1[3]);
  #pragma unroll
  for(int r=4;r<16;r+=4){a=max3f(a,p0[r],p0[r+1]);b=max3f(b,p0[r+2],p0[r+3]);a=max3f(a,p1[r],p1[r+1]);b=max3f(b,p1[r+2],p1[r+3]);}
  const float m=max2f(a,b);
  auto rr=__builtin_amdgcn_permlane32_swap(__float_as_uint(m),__float_as_uint(m),false,false);
  return max2f(__uint_as_float(rr[0]),__uint_as_float(rr[1]));
}
__device__ __forceinline__ void pv(f32x16*o,int vb,bf16x8 pa0,bf16x8 pa1,bf16x8 pa2,bf16x8 pa3){
  #pragma unroll
  for(int d0=0;d0<2;++d0){s16x4 lo[4],hi[4];
    #pragma unroll
    for(int ks=0;ks<4;++ks){
      asm volatile("ds_read_b64_tr_b16 %0,%1 offset:%c2":"=&v"(lo[ks]):"v"(vb),"i"(d0*4096+ks*1024):"memory");
      asm volatile("ds_read_b64_tr_b16 %0,%1 offset:%c2":"=&v"(hi[ks]):"v"(vb),"i"(d0*4096+ks*1024+512):"memory");}
    asm volatile("s_waitcnt lgkmcnt(0)":::"memory");SBAR();
    #define PK(k) (bf16x8){lo[k][0],lo[k][1],lo[k][2],lo[k][3],hi[k][0],hi[k][1],hi[k][2],hi[k][3]}
    o[d0]=__builtin_amdgcn_mfma_f32_32x32x16_bf16(pa0,PK(0),o[d0],0,0,0);
    o[d0]=__builtin_amdgcn_mfma_f32_32x32x16_bf16(pa1,PK(1),o[d0],0,0,0);
    o[d0]=__builtin_amdgcn_mfma_f32_32x32x16_bf16(pa2,PK(2),o[d0],0,0,0);
    o[d0]=__builtin_amdgcn_mfma_f32_32x32x16_bf16(pa3,PK(3),o[d0],0,0,0);
    #undef PK
  }
}

#ifndef ATTN_STORE16
#define ATTN_STORE16(p,v) (*(u32x4*)(p)=(v))
#endif
#ifndef ATTN_QLDS
#define ATTN_QLDS 0
#endif
#ifndef ATTN_NEGM_MASK
#define ATTN_NEGM_MASK 0x6
#endif
template<int MODE,int THRL> __device__ __forceinline__ void attn_unit(int b,int qc,int kc,int vc,int oc,int hq,int grp,int qb,const AArgs&A_,char*shm,const bool epi_=false){
  const bool EPI=(MODE==3)&&epi_;
  AArgs A=A_;
  asm volatile("":"+s"(A.Q),"+s"(A.K),"+s"(A.V),"+s"(A.O)); asm volatile("":"+s"(A.cosT),"+s"(A.sinT),"+s"(A.sel)); asm volatile("":"+s"(A.ocmp),"+s"(A.owin),"+s"(A.ga)); asm volatile("":"+s"(A.subln),"+s"(A.ob),"+s"(A.lamp));
  int tid_=threadIdx.x; asm volatile("":"+v"(tid_)); const int tid=tid_,lane=tid&63,r32=lane&31,hi=lane>>5; const int wid=__builtin_amdgcn_readfirstlane(tid>>6);
  const long rowbase=(long)b*SEQ; const int q0=qb*QB; constexpr int qp=512,kp=(MODE==0||MODE==3)?512:128,vp=kp,op=(MODE==0||MODE==3)?1024:512;
  constexpr int NDB=(MODE==3)?4:2,VMUL=NDB/2;
  constexpr int L_WS=LDS_V+NSLOT*SLOTB*VMUL,L_OST=L_WS+NW*64*4,OSTW=(MODE==3)?8192:4096;
  const int ts=(MODE==1)?((4*qb-8)>0?(4*qb-8):0):0;
  const bf16*Qw=A.Q+(rowbase+q0+wid*QBLK)*qp+qc;
  const bf16*Kh=A.K+(rowbase+(long)ts*KVBLK)*kp+kc,*Vh=A.V+(rowbase+(long)ts*KVBLK)*vp+vc;
  const unsigned lds0=(unsigned)(uintptr_t)shm;
  float*wsf=(float*)(shm+L_WS)+wid*64;
  const bf16*ksrc=Kh+(long)lane*kp+wid*8;
  const bf16*vsrc=Vh+(long)(16*(wid&3)+(lane>>2))*vp+(wid>>2)*32+(lane&3)*8;
  const unsigned kdst=lds0+LDS_K+wid*1024, vdst=lds0+LDS_V+wid*1024;
  #define DMA_K(t,slot) glds16(ksrc+(long)(t)*KVBLK*kp,(unsigned)__builtin_amdgcn_readfirstlane(kdst+(slot)))
  #define DMA_V(t,slot) do{ glds16(vsrc+(long)(t)*KVBLK*vp,(unsigned)__builtin_amdgcn_readfirstlane(vdst+(slot)*VMUL)); if(MODE==3) glds16(vsrc+64+(long)(t)*KVBLK*vp,(unsigned)__builtin_amdgcn_readfirstlane(vdst+(slot)*VMUL+8192)); }while(0)
  #define WB3() do{ if(MODE==3){WAIT_BAR(4);} else {WAIT_BAR(3);} }while(0)
  #define WB2() do{ if(MODE==3){WAIT_BAR(3);} else {WAIT_BAR(2);} }while(0)
  #define WB1() do{ if(MODE==3){WAIT_BAR(2);} else {WAIT_BAR(1);} }while(0)
  const int vb0=(int)(lds0+LDS_V)+((lane>>4)&1)*32+(lane&3)*8+(4*hi+((lane&15)>>2))*64;
  const char*Kbase=shm+LDS_K; bf16x8 kf[8];
  const lds_cptr shm3=(lds_cptr)shm; const lds_cptr kp0=shm3+LDS_K+hi*1024+r32*16; const lds_cptr vp0=shm3+LDS_V+((lane>>4)&1)*32+(lane&3)*8+(4*hi+((lane&15)>>2))*64;
  const int NT=(q0+QB)/KVBLK-ts;
  DMA_K(0,0);DMA_V(0,0);DMA_K(1,SLOTB);
  bf16x8 qr[4];
  #pragma unroll
  for(int d0=0;d0<4;++d0)qr[d0]=*reinterpret_cast<const bf16x8*>(&Qw[(long)r32*qp+d0*16+hi*8]);
  u32x4 sel=(u32x4){0u,0u,0u,0u};
  if(MODE==1||MODE==2){
    const long qrow=rowbase+q0+wid*QBLK+r32;
    #pragma unroll
    for(int d0=0;d0<4;++d0){ const int g8=2*d0+hi; const f32x4_t c=*reinterpret_cast<const f32x4_t*>(A.cosT+qrow*32+4*g8), s=*reinterpret_cast<const f32x4_t*>(A.sinT+qrow*32+4*g8);
      u32x4 w;
      #pragma unroll
      for(int j=0;j<4;++j){ const float x1=bf2f(qr[d0][j]),x2=bf2f(qr[d0][j+4]); const float y1=x1*c[j]-x2*s[j], y2=x2*c[j]+x1*s[j]; qr[d0][j]=(short)(cvtpk_s(y1,0.f)&0xffffu); qr[d0][j+4]=(short)(cvtpk_s(y2,0.f)&0xffffu); }
    }
    if(MODE==2) sel=A.sel[qrow*2+grp];
  }
  typedef __attribute__((address_space(3))) bf16x8 lds_bf16x8;
  lds_bf16x8*qst=(lds_bf16x8*)(shm3+L_OST+wid*OSTW)+lane;
  constexpr bool QLDS=(MODE==3)&&(ATTN_QLDS!=0);
  if(QLDS){
    #pragma unroll
    for(int d0=0;d0<4;++d0)qst[d0*64]=qr[d0];
    asm volatile("s_waitcnt lgkmcnt(0)":::"memory"); }
  #define QR(d) (QLDS?(bf16x8)qst[(d)*64]:qr[d])
  float mhat=0.f,l_reg=0.f;f32x16 o[NDB];
  #pragma unroll
  for(int d_=0;d_<NDB;++d_)o[d_]=f32x16{};
  constexpr bool NEGM=((ATTN_NEGM_MASK>>MODE)&1)!=0; f32x16 negm=f32x16{}; if(NEGM) asm volatile("":"+v"(negm));
  const int qrel=wid*QBLK+r32;
  #define CMASK(P0,P1,t) tmask<MODE>(P0,P1,(t),NT,qrel,hi,sel)
  bool resc=false;
  #define START(P0,P1) do{ const float rm=rowmax(P0,P1); resc=false; \
    { const float dl=__builtin_fmaxf(rm,-1000.f); mhat=fadd_s(mhat,dl); \
      _Pragma("unroll") for(int r=0;r<16;++r){P0[r]=fsub_s(P0[r],dl);P1[r]=fsub_s(P1[r],dl);} \
      if(NEGM){ _Pragma("unroll") for(int r=0;r<16;++r)negm[r]=-mhat; asm volatile("":"+v"(negm)); } } \
    _Pragma("unroll") for(int r=0;r<16;++r)P0[r]=__builtin_amdgcn_exp2f(P0[r]); }while(0)
  #define RESC() do{ if(resc){ asm volatile("s_waitcnt lgkmcnt(0)":::"memory"); \
      _Pragma("unroll") for(int d_=0;d_<NDB;++d_) _Pragma("unroll") for(int r=0;r<16;++r)o[d_][r]*=wsf[crow(r,hi)]; } }while(0)
  f32x16 pA0,pA1,pB0,pB1;
  int sl_prev=0,sl_cur=0,sl_next=SLOTB;
  #define ROT() do{sl_prev=sl_cur;sl_cur=sl_next;sl_next=(sl_next==(NSLOT-1)*SLOTB)?0:sl_next+SLOTB;}while(0)
  DMA_K(2,2*SLOTB);
  WB3();
  { bf16x8 q4_[4]; _Pragma("unroll") for(int d_=0;d_<4;++d_)q4_[d_]=QR(d_); qkt(pA0,pA1,Kbase,q4_,negm,r32,hi); }asm volatile("s_nop 15\n\ts_nop 7":"+v"(pA0),"+v"(pA1));CMASK(pA0,pA1,0);
  START(pA0,pA1);
  _Pragma("unroll") for(int r=0;r<16;++r)pA1[r]=__builtin_amdgcn_exp2f(pA1[r]);
  WAIT_BAR(0);
  DMA_K(3,0);DMA_V(1,SLOTB);
  ROT();
  kload8(kf,kp0+sl_cur);
  WB2();
  s16x4 vlo[8],vhi[8]; u32x4 pw0,pw1,pw2,pw3;
  constexpr bool PSEL=(MODE==2)&&NEGM; unsigned onm_p=0xffffffffu; float onf_p=1.f;
  #define PKW(P,B) (PSEL?(cvtpk_s(P[B],P[B+1])&onm_p):cvtpk_s(P[B],P[B+1]))
  #define PAF(k) __builtin_bit_cast(bf16x8,pw##k)
  #define VFR(i) (bf16x8){vlo[i][0],vlo[i][1],vlo[i][2],vlo[i][3],vhi[i][0],vhi[i][1],vhi[i][2],vhi[i][3]}
  #define PIN(x) asm volatile("":"+v"(x))
  #define MX3(a,b,c) __builtin_fmaxf(__builtin_fmaxf((a),(b)),(c))
  #define GAPA(MF,A0,A1,A2,A3,W0,W1,PW) do{ MF; sacc+=A0; sacc+=A1; sacc+=A2; sacc+=A3; PIN(sacc); W0; W1; PIN(PW); SBAR(); }while(0)
  #define EX(v) (NEGM?__builtin_amdgcn_exp2f(v):__builtin_amdgcn_exp2f((v)-msub_))
  #define GAPB(MF,X,B) do{ MF; X[B]=EX(X[B]); X[B+1]=EX(X[B+1]); X[B+2]=EX(X[B+2]); X[B+3]=EX(X[B+3]); PIN(X); SBAR(); }while(0)
  #define GAPB2(MF,X,B) do{ MF; X[B]=EX(X[B]); X[B+1]=EX(X[B+1]); PIN(X); SBAR(); }while(0)
  #define VRD2(i) do{ vlo[i]=vtr(vq_+(((i)>>2)*4096+((i)&3)*1024)); vhi[i]=vtr(vq_+(((i)>>2)*4096+((i)&3)*1024+512)); }while(0)
  #define VRD(i) do{ vlo[i]=vtr(vp_+(((i)>>2)*4096+((i)&3)*1024)); vhi[i]=vtr(vp_+(((i)>>2)*4096+((i)&3)*1024+512)); }while(0)
  #define KRD(G,j) do{ if(G){ kload2(kf,kp0+sl_next,j); SBAR(); } }while(0)
  #define STEP(C0,C1,P0,P1,t,GK,GV,GL) do{ SBAR(); \
    const lds_cptr vp_=vp0+sl_prev*VMUL; \
    bf16x8 qa_=qn0,qb_; VRD(0); SBAR(); float sacc=(P0[0]+P0[1]); \
    GAPA(C0=__builtin_amdgcn_mfma_f32_32x32x16_bf16(kf[0],qa_,negm,0,0,0), P0[2],P0[3],P0[4],P0[5],     pw0[0]=PKW(P0,0), pw0[1]=PKW(P0,2), pw0); \
    VRD(4); qb_=QR(1); SBAR(); GAPA(C1=__builtin_amdgcn_mfma_f32_32x32x16_bf16(kf[1],qa_,negm,0,0,0), P0[6],P0[7],P0[8],P0[9],     pw0[2]=PKW(P0,4), pw0[3]=PKW(P0,6), pw0); \
    VRD(1); SBAR(); GAPA(C0=__builtin_amdgcn_mfma_f32_32x32x16_bf16(kf[2],qb_,C0,0,0,0),   P0[10],P0[11],P0[12],P0[13], pw1[0]=PKW(P0,8), pw1[1]=PKW(P0,10), pw1); \
    VRD(5); qa_=QR(2); SBAR(); GAPA(C1=__builtin_amdgcn_mfma_f32_32x32x16_bf16(kf[3],qb_,C1,0,0,0),   P0[14],P0[15],P1[0],P1[1],   pw1[2]=PKW(P0,12),pw1[3]=PKW(P0,14), pw1); \
    VRD(2); SBAR(); GAPA(C0=__builtin_amdgcn_mfma_f32_32x32x16_bf16(kf[4],qa_,C0,0,0,0),   P1[2],P1[3],P1[4],P1[5],     pw2[0]=PKW(P1,0), pw2[1]=PKW(P1,2), pw2); \
    VRD(6); qb_=QR(3); SBAR(); GAPA(C1=__builtin_amdgcn_mfma_f32_32x32x16_bf16(kf[5],qa_,C1,0,0,0),   P1[6],P1[7],P1[8],P1[9],     pw2[2]=PKW(P1,4), pw2[3]=PKW(P1,6), pw2); \
    VRD(3); SBAR(); GAPA(C0=__builtin_amdgcn_mfma_f32_32x32x16_bf16(kf[6],qb_,C0,0,0,0),   P1[10],P1[11],P1[12],P1[13], pw3[0]=PKW(P1,8), pw3[1]=PKW(P1,10), pw3); \
    VRD(7); SBAR(); GAPA(C1=__builtin_amdgcn_mfma_f32_32x32x16_bf16(kf[7],qb_,C1,0,0,0),   P1[14],P1[15],0.f,0.f,       pw3[2]=PKW(P1,12),pw3[3]=PKW(P1,14), pw3); \
    l_reg+=PSEL?sacc*onf_p:sacc; qn0=QR(0); \
    if(PSEL){ const int tt_=(t); const unsigned w_=(tt_<32)?sel[0]:(tt_<64)?sel[1]:(tt_<96)?sel[2]:sel[3]; const bool on2_=((w_>>(tt_&31))&1u)!=0u; onm_p=on2_?0xffffffffu:0u; onf_p=on2_?1.f:0.f; } \
    if(GK){DMA_K((t)+3,sl_cur);} if(GV){DMA_V((t)+1,sl_next);} \
    bool on_=true; if(!NEGM&&MODE==2){ const int tt_=(t); const unsigned w_=(tt_<32)?sel[0]:(tt_<64)?sel[1]:(tt_<96)?sel[2]:sel[3]; on_=((w_>>(tt_&31))&1u)!=0u; } \
    CMASK(C0,C1,t); \
    { float a=MX3(C0[0],C0[1],C1[0]),b=MX3(C0[2],C0[3],C1[1]); a=MX3(a,C1[2],C1[3]); \
      _Pragma("unroll") for(int r=4;r<16;r+=4){a=MX3(a,C0[r],C0[r+1]);b=MX3(b,C0[r+2],C0[r+3]);a=MX3(a,C1[r],C1[r+1]);b=MX3(b,C1[r+2],C1[r+3]);} \
      float rm=__builtin_fmaxf(a,b); { auto rr=__builtin_amdgcn_permlane32_swap(__float_as_uint(rm),__float_as_uint(rm),false,false); rm=__builtin_fmaxf(__uint_as_float(rr[0]),__uint_as_float(rr[1])); } \
      if(!NEGM) rm-=mhat;     \
      resc=false; \
      if(__builtin_expect(__any(rm>(float)THRL),0)){ const float dl=__builtin_fmaxf(rm,0.f); mhat+=dl; \
        if(NEGM){ _Pragma("unroll") for(int r=0;r<16;++r){C0[r]-=dl;C1[r]-=dl;} } \
        if(NEGM){ _Pragma("unroll") for(int r=0;r<16;++r)negm[r]=-mhat; asm volatile("":"+v"(negm)); } \
        const float f=__builtin_amdgcn_exp2f(-dl); l_reg*=f; if(hi==0)wsf[r32]=f; resc=true; } } \
    const float msub_=on_?mhat:INFINITY;     \
    SBAR(); \
    if(MODE==3){ const lds_cptr vq_=vp_+8192;     \
      GAPB2(o[0]=__builtin_amdgcn_mfma_f32_32x32x16_bf16(PAF(0),VFR(0),o[0],0,0,0), C0,0); VRD2(0); SBAR(); \
      GAPB2(o[1]=__builtin_amdgcn_mfma_f32_32x32x16_bf16(PAF(0),VFR(4),o[1],0,0,0), C0,2); VRD2(4); SBAR(); \
      KRD(GL,0); GAPB2(o[0]=__builtin_amdgcn_mfma_f32_32x32x16_bf16(PAF(1),VFR(1),o[0],0,0,0), C0,4); VRD2(1); SBAR(); \
      KRD(GL,1); GAPB2(o[1]=__builtin_amdgcn_mfma_f32_32x32x16_bf16(PAF(1),VFR(5),o[1],0,0,0), C0,6); VRD2(5); SBAR(); \
      KRD(GL,2); GAPB2(o[0]=__builtin_amdgcn_mfma_f32_32x32x16_bf16(PAF(2),VFR(2),o[0],0,0,0), C0,8); VRD2(2); SBAR(); \
      KRD(GL,3); GAPB2(o[1]=__builtin_amdgcn_mfma_f32_32x32x16_bf16(PAF(2),VFR(6),o[1],0,0,0), C0,10); VRD2(6); SBAR(); \
      GAPB2(o[0]=__builtin_amdgcn_mfma_f32_32x32x16_bf16(PAF(3),VFR(3),o[0],0,0,0), C0,12); VRD2(3); SBAR(); \
      GAPB2(o[1]=__builtin_amdgcn_mfma_f32_32x32x16_bf16(PAF(3),VFR(7),o[1],0,0,0), C0,14); VRD2(7); SBAR(); \
      GAPB2(o[2]=__builtin_amdgcn_mfma_f32_32x32x16_bf16(PAF(0),VFR(0),o[2],0,0,0), C1,0); \
      GAPB2(o[3]=__builtin_amdgcn_mfma_f32_32x32x16_bf16(PAF(0),VFR(4),o[3],0,0,0), C1,2); \
      GAPB2(o[2]=__builtin_amdgcn_mfma_f32_32x32x16_bf16(PAF(1),VFR(1),o[2],0,0,0), C1,4); \
      GAPB2(o[3]=__builtin_amdgcn_mfma_f32_32x32x16_bf16(PAF(1),VFR(5),o[3],0,0,0), C1,6); \
      GAPB2(o[2]=__builtin_amdgcn_mfma_f32_32x32x16_bf16(PAF(2),VFR(2),o[2],0,0,0), C1,8); \
      GAPB2(o[3]=__builtin_amdgcn_mfma_f32_32x32x16_bf16(PAF(2),VFR(6),o[3],0,0,0), C1,10); \
      GAPB2(o[2]=__builtin_amdgcn_mfma_f32_32x32x16_bf16(PAF(3),VFR(3),o[2],0,0,0), C1,12); \
      GAPB2(o[3]=__builtin_amdgcn_mfma_f32_32x32x16_bf16(PAF(3),VFR(7),o[3],0,0,0), C1,14); \
    } else { \
    GAPB(o[0]=__builtin_amdgcn_mfma_f32_32x32x16_bf16(PAF(0),VFR(0),o[0],0,0,0), C0,0); \
    GAPB(o[1]=__builtin_amdgcn_mfma_f32_32x32x16_bf16(PAF(0),VFR(4),o[1],0,0,0), C0,4); \
    KRD(GL,0); GAPB(o[0]=__builtin_amdgcn_mfma_f32_32x32x16_bf16(PAF(1),VFR(1),o[0],0,0,0), C0,8); \
    KRD(GL,1); GAPB(o[1]=__builtin_amdgcn_mfma_f32_32x32x16_bf16(PAF(1),VFR(5),o[1],0,0,0), C0,12); \
    KRD(GL,2); GAPB(o[0]=__builtin_amdgcn_mfma_f32_32x32x16_bf16(PAF(2),VFR(2),o[0],0,0,0), C1,0); \
    KRD(GL,3); GAPB(o[1]=__builtin_amdgcn_mfma_f32_32x32x16_bf16(PAF(2),VFR(6),o[1],0,0,0), C1,4); \
    GAPB(o[0]=__builtin_amdgcn_mfma_f32_32x32x16_bf16(PAF(3),VFR(3),o[0],0,0,0), C1,8); \
    GAPB(o[1]=__builtin_amdgcn_mfma_f32_32x32x16_bf16(PAF(3),VFR(7),o[1],0,0,0), C1,12); \
    } \
    }while(0)
  int t=1; bf16x8 qn0=QR(0);
  #undef CMASK
  #define CMASK(P0,P1,t) do{ if(MODE==1) tmask<MODE>(P0,P1,(t),NT,qrel,hi,sel); }while(0)
  for(;t+5<NT;t+=2){
    STEP(pB0,pB1,pA0,pA1,t,true,true,true);     WB2(); RESC(); ROT();
    STEP(pA0,pA1,pB0,pB1,t+1,true,true,true);   WB2(); RESC(); ROT();
  }
  #undef CMASK
  #define CMASK(P0,P1,t) tmask<MODE,false>(P0,P1,(t),NT,qrel,hi,sel)
  #define ENDW(tt) do{ if((tt)+3<NT){WB2();} else if((tt)+2<NT){WB1();} else {WAIT_BAR(0);} }while(0)
  for(;t+1<NT;t+=2){
    STEP(pB0,pB1,pA0,pA1,t,(t+3<NT),(t+1<NT),(t+1<NT));       ENDW(t);   RESC(); ROT();
    STEP(pA0,pA1,pB0,pB1,t+1,(t+4<NT),(t+2<NT),(t+2<NT));     ENDW(t+1); RESC(); ROT();
  }
  STEP(pB0,pB1,pA0,pA1,NT-1,false,false,false); RESC();
  { float sacc=pB0[0]+pB0[1]; _Pragma("unroll") for(int r=2;r<16;++r)sacc+=pB0[r]; _Pragma("unroll") for(int r=0;r<16;++r)sacc+=pB1[r]; l_reg+=PSEL?sacc*onf_p:sacc;
    pw0=(u32x4){PKW(pB0,0),PKW(pB0,2),PKW(pB0,4),PKW(pB0,6)};pw1=(u32x4){PKW(pB0,8),PKW(pB0,10),PKW(pB0,12),PKW(pB0,14)};pw2=(u32x4){PKW(pB1,0),PKW(pB1,2),PKW(pB1,4),PKW(pB1,6)};pw3=(u32x4){PKW(pB1,8),PKW(pB1,10),PKW(pB1,12),PKW(pB1,14)};
    SBAR(); pv(o,vb0+sl_cur*VMUL,PAF(0),PAF(1),PAF(2),PAF(3)); if(MODE==3) pv(o+(NDB-2),vb0+sl_cur*VMUL+8192,PAF(0),PAF(1),PAF(2),PAF(3)); }
  #undef PKW
  #undef PAF
  #undef VFR
  #undef PIN
  #undef MX3
  #undef GAPA
  #undef GAPB
  #undef EX
  #undef VRD
  #undef VRD2
  #undef GAPB2
  #undef KRD
  #undef STEP
  #undef ENDW
  {auto rr=__builtin_amdgcn_permlane32_swap(__float_as_uint(l_reg),__float_as_uint(l_reg),false,false);l_reg=__uint_as_float(rr[0])+__uint_as_float(rr[1]);}
  if(hi==0)wsf[32+r32]=l_reg;asm volatile("s_waitcnt lgkmcnt(0)":::"memory");
  float rli[16];
  #pragma unroll
  for(int r=0;r<16;++r)rli[r]=__builtin_amdgcn_rcpf(wsf[32+crow(r,hi)]);
  bf16*Ow=A.O+(rowbase+q0+wid*QBLK)*op+oc;
  u32x4 c8_[4],w8_[4]; float gg_[4][3];
  if(MODE==2){
    #pragma unroll
    for(int i=0;i<4;++i){ const int row=i*8+(lane>>3),ch=lane&7; const long grow=rowbase+q0+wid*QBLK+row;
      c8_[i]=*(const u32x4*)(A.ocmp+grow*512+hq*64+ch*8); w8_[i]=*(const u32x4*)(A.owin+grow*512+hq*64+ch*8);
      gg_[i][0]=A.ga[grow*24+hq*3+0]; gg_[i][1]=A.ga[grow*24+hq*3+1]; gg_[i][2]=A.ga[grow*24+hq*3+2]; } }
  if(!EPI)
  #pragma unroll
  for(int h2=0;h2<NDB/2;++h2){ bf16*stg=(bf16*)(shm+L_OST)+wid*(OSTW/2);
    #pragma unroll
    for(int r=0;r<16;++r){const int orow=crow(r,hi);
      #pragma unroll
      for(int d0=0;d0<2;++d0)stg[orow*64+d0*32+r32]=__float2bfloat16(o[2*h2+d0][r]*rli[r]);}
    asm volatile("s_waitcnt lgkmcnt(0)":::"memory");
    #pragma unroll
    for(int i=0;i<4;++i){const int row=i*8+(lane>>3),ch=lane&7; u32x4 v=*(const u32x4*)(stg+row*64+ch*8);
      if(MODE==2){ const u32x4 c8=c8_[i], w8=w8_[i]; const float g0=gg_[i][0],g1=gg_[i][1],g2=gg_[i][2];
        #pragma unroll
        for(int k=0;k<4;++k){ const float lo=g0*__uint_as_float(c8[k]<<16)+g1*__uint_as_float(v[k]<<16)+g2*__uint_as_float(w8[k]<<16);
          const float hi2=g0*__uint_as_float(c8[k]&0xffff0000u)+g1*__uint_as_float(v[k]&0xffff0000u)+g2*__uint_as_float(w8[k]&0xffff0000u); v[k]=cvtpk_s(lo,hi2); } }
      ATTN_STORE16(Ow+(long)row*op+h2*64+ch*8,v);}
    asm volatile("s_waitcnt lgkmcnt(0)":::"memory"); }
  if(EPI){ const int hd=oc>>8;
    bf16*stg=(bf16*)(shm+L_OST)+wid*(OSTW/2);
    const float lam_=A.lamp[0],post_=A.lamp[1];
    #pragma unroll
    for(int r=0;r<16;++r){const int orow=crow(r,hi);
      #pragma unroll
      for(int d0=0;d0<NDB;++d0)stg[orow*128+d0*32+r32]=__float2bfloat16(o[d0][r]*rli[r]);}
    asm volatile("s_waitcnt lgkmcnt(0)":::"memory");
    #pragma unroll
    for(int i=0;i<4;++i){ const int row=i*8+(lane>>3),ch=lane&7; const long grow=rowbase+q0+wid*QBLK+row; float av[2][8]; float ss=0.f;
      #pragma unroll
      for(int h2=0;h2<2;++h2){ const u32x4 v=*(const u32x4*)(stg+row*128+h2*64+ch*8); const u32x4 o1=*(const u32x4*)(Ow+(long)row*op-128+h2*64+ch*8);
        #pragma unroll
        for(int k=0;k<4;++k){ const float lo=__uint_as_float(o1[k]<<16)-lam_*__uint_as_float(v[k]<<16), hi2=__uint_as_float(o1[k]&0xffff0000u)-lam_*__uint_as_float(v[k]&0xffff0000u);
          av[h2][2*k]=lo; av[h2][2*k+1]=hi2; ss+=lo*lo+hi2*hi2; } }
      ss+=__shfl_xor(ss,1); ss+=__shfl_xor(ss,2); ss+=__shfl_xor(ss,4);
      const float rs=post_*__builtin_amdgcn_rsqf(ss*(1.0f/128.0f)+1e-6f);
      #pragma unroll
      for(int h2=0;h2<2;++h2){ const f32x4_t g0=*reinterpret_cast<const f32x4_t*>(A.subln+h2*64+ch*8), g1=*reinterpret_cast<const f32x4_t*>(A.subln+h2*64+ch*8+4);
        u32x4 w; w[0]=cvtpk_s(av[h2][0]*rs*g0[0],av[h2][1]*rs*g0[1]); w[1]=cvtpk_s(av[h2][2]*rs*g0[2],av[h2][3]*rs*g0[3]); w[2]=cvtpk_s(av[h2][4]*rs*g1[0],av[h2][5]*rs*g1[1]); w[3]=cvtpk_s(av[h2][6]*rs*g1[2],av[h2][7]*rs*g1[3]);
        *(u32x4*)(A.ob+grow*512+hd*128+h2*64+ch*8)=w; } } }
  asm volatile("s_waitcnt lgkmcnt(0)\n\ts_barrier":::"memory");
  #undef DMA_K
  #undef DMA_V
  #undef QR
  #undef WB3
  #undef WB2
  #undef WB1
  #undef CMASK
  #undef START
  #undef RESC
  #undef ROT
}
constexpr int ATTN_LDS_BYTES=LDS_BYTES;
#undef SBAR
#undef WAIT_BAR
}

#define LAS __attribute__((address_space(3)))
typedef unsigned short bf16_t;
typedef short bf16x8 __attribute__((ext_vector_type(8)));
typedef float f32x4 __attribute__((ext_vector_type(4)));
typedef unsigned u32x4 __attribute__((ext_vector_type(4)));
typedef unsigned u32x2 __attribute__((ext_vector_type(2)));
constexpr int NB = 4, SEQ = 8192, DMODEL = 1024, MTOK = NB * SEQ, NCAT = 7168, DFF = 2816, NFF13 = 2 * DFF, DIN = 3864;
constexpr float C2 = 0.125f * 1.4426950408889634f, EPS = 1e-6f;
constexpr size_t KiB = 1024, MiB = 1u << 20;
constexpr size_t WS_BIAS1 = 0, WS_KC = 64 * KiB, WS_VCT = 576 * KiB, WS_WC2 = 1536 * KiB;
constexpr size_t WS_COS = 2 * MiB, WS_SIN = 6 * MiB;
constexpr size_t WS_WCAT = 10 * MiB, WS_WBR = 24 * MiB, WS_WOUT = 27 * MiB, WS_W13 = 29 * MiB, WS_W2 = 40 * MiB, WS_WC1 = 46 * MiB;
constexpr size_t WS_H64 = 48 * MiB;
constexpr size_t WS_QA = 112 * MiB, WS_KCMP = 144 * MiB, WS_VCMP = 152 * MiB, WS_KSLC = 160 * MiB, WS_VSLC = 168 * MiB, WS_KWIN = 176 * MiB, WS_VWIN = 184 * MiB;
constexpr size_t WS_QB = 192 * MiB, WS_KB = 224 * MiB, WS_VB = 256 * MiB, WS_U = 288 * MiB, WS_V = 320 * MiB, WS_GA = 352 * MiB;
constexpr size_t WS_HID = 112 * MiB, WS_OCMP = WS_V;
constexpr size_t WS_GATES = 356 * MiB, WS_OWIN = 452 * MiB, WS_SEL = 484 * MiB, WS_END = 486 * MiB;
constexpr int LDS_BYTES = 159744, LDS_BARW = LDS_BYTES - 64;
constexpr size_t WS_LAM = 1624 * KiB;
constexpr size_t WS_BAR = 1600 * KiB, WS_BAR_BYTES = 16 * KiB;

struct KArgs { const void* in[29]; float* out; unsigned char* ws; };
typedef const void* const __attribute__((address_space(4)))* KP;
struct KIn { KP p; __device__ __forceinline__ const void* operator[](int i) const { return p[i]; } };
struct KA { KIn in; float* out; unsigned char* ws; };
__device__ __forceinline__ KA make_ka() { KP p = (KP)__builtin_amdgcn_kernarg_segment_ptr(); asm volatile("" : "+s"(p)); KA a; a.in.p = p; a.out = (float*)p[29]; a.ws = (unsigned char*)p[30]; return a; }

__device__ __forceinline__ float wave_sum(float v) {
#pragma unroll
    for (int o = 1; o < 64; o <<= 1) v += __shfl_xor(v, o);
    return v;
}
__device__ __forceinline__ unsigned pk2(float lo, float hi) { return pg8::cvt_pk_bf16(lo, hi); }
__device__ __forceinline__ float bflo(unsigned w) { return __uint_as_float(w << 16); }
__device__ __forceinline__ float bfhi(unsigned w) { return __uint_as_float(w & 0xffff0000u); }
__device__ __forceinline__ int rope_perm(int p) { const int g8 = p >> 3, j = p & 7; return (j < 4) ? 4 * g8 + j : 32 + 4 * g8 + (j - 4); }
__device__ __forceinline__ f32x4 mfma16(bf16x8 a, bf16x8 b, f32x4 c) { return __builtin_amdgcn_mfma_f32_16x16x32_bf16(a, b, c, 0, 0, 0); }
#define LDS_WAIT() asm volatile("s_waitcnt lgkmcnt(0)" ::: "memory")

template <class F> __device__ __forceinline__ void conv_items(bf16_t* dst, int K, int ndest, F colp, LAS float* scr, int gw, int NGW, int lane) {
    const int nblk = ndest / 32, items = nblk * (K / 64);
    for (int it = gw; it < items; it += NGW) {
        const int nb = it % nblk, kb = it / nblk, n0 = nb * 32, k0 = kb * 64;
        const float* cp; int ld; colp(n0 + (lane & 7) * 4, cp, ld);
#pragma unroll
        for (int i = 0; i < 8; ++i) { const int kk = 8 * i + (lane >> 3); const f32x4 v = cp ? *(const f32x4*)(cp + (size_t)(k0 + kk) * ld) : (f32x4){0.f, 0.f, 0.f, 0.f};
            LAS float* d = scr + kk * 33 + (lane & 7) * 4; d[0] = v.x; d[1] = v.y; d[2] = v.z; d[3] = v.w; }
        LDS_WAIT();
        const int c = lane & 7;
#pragma unroll
        for (int j = 0; j < 4; ++j) { const int n = (lane >> 3) + 8 * j; const LAS float* s = scr + (8 * c) * 33 + n;
            u32x4 o; o.x = pk2(s[0 * 33], s[1 * 33]); o.y = pk2(s[2 * 33], s[3 * 33]); o.z = pk2(s[4 * 33], s[5 * 33]); o.w = pk2(s[6 * 33], s[7 * 33]);
            *(u32x4*)(dst + (size_t)(n0 + n) * K + k0 + 8 * c) = o; }
        LDS_WAIT();
    }
}

__device__ __forceinline__ void rms_rows_bf16(const float* x, const float* gain, bf16_t* out, int gw, int NGW, int lane) {
    for (int m = gw; m < MTOK; m += 2 * NGW) {
        const int m2 = (m + NGW < MTOK) ? m + NGW : m;
        const f32x4* xr = (const f32x4*)(x + (size_t)m * DMODEL) + lane; const f32x4* xr2 = (const f32x4*)(x + (size_t)m2 * DMODEL) + lane; f32x4 v[4], w[4]; float s = 0.f, s2 = 0.f;
#pragma unroll
        for (int j = 0; j < 4; ++j) { v[j] = xr[64 * j]; w[j] = xr2[64 * j]; }
#pragma unroll
        for (int j = 0; j < 4; ++j) { s += (v[j].x * v[j].x + v[j].y * v[j].y) + (v[j].z * v[j].z + v[j].w * v[j].w); s2 += (w[j].x * w[j].x + w[j].y * w[j].y) + (w[j].z * w[j].z + w[j].w * w[j].w); }
        const float rs = 1.0f / sqrtf(wave_sum(s) * (1.0f / DMODEL) + EPS), rs2 = 1.0f / sqrtf(wave_sum(s2) * (1.0f / DMODEL) + EPS);
        u32x2* o = (u32x2*)(out + (size_t)m * DMODEL) + lane; u32x2* o2 = (u32x2*)(out + (size_t)m2 * DMODEL) + lane;
#pragma unroll
        for (int j = 0; j < 4; ++j) { const f32x4 g = ((const f32x4*)gain)[64 * j + lane]; const f32x4 y = v[j] * rs * g, y2 = w[j] * rs2 * g; o[64 * j] = (u32x2){pk2(y.x, y.y), pk2(y.z, y.w)}; o2[64 * j] = (u32x2){pk2(y2.x, y2.y), pk2(y2.z, y2.w)}; }
    }
}
__device__ __forceinline__ void rms_rows_f32(float* x, const float* gain, int gw, int NGW, int lane) {
    for (int m = gw; m < MTOK; m += 2 * NGW) {
        const int m2 = (m + NGW < MTOK) ? m + NGW : m;
        f32x4* xr = (f32x4*)(x + (size_t)m * DMODEL) + lane; f32x4* xr2 = (f32x4*)(x + (size_t)m2 * DMODEL) + lane; f32x4 v[4], w[4]; float s = 0.f, s2 = 0.f;
#pragma unroll
        for (int j = 0; j < 4; ++j) { v[j] = xr[64 * j]; w[j] = xr2[64 * j]; }
#pragma unroll
        for (int j = 0; j < 4; ++j) { s += (v[j].x * v[j].x + v[j].y * v[j].y) + (v[j].z * v[j].z + v[j].w * v[j].w); s2 += (w[j].x * w[j].x + w[j].y * w[j].y) + (w[j].z * w[j].z + w[j].w * w[j].w); }
        const float rs = 1.0f / sqrtf(wave_sum(s) * (1.0f / DMODEL) + EPS), rs2 = 1.0f / sqrtf(wave_sum(s2) * (1.0f / DMODEL) + EPS);
#pragma unroll
        for (int j = 0; j < 4; ++j) { const f32x4 g = ((const f32x4*)gain)[64 * j + lane]; xr[64 * j] = v[j] * rs * g; if (m2 != m) xr2[64 * j] = w[j] * rs2 * g; }
    }
}

__device__ __forceinline__ void phase0(const KA& a, int layer, const float* xin, LAS unsigned char* lds, int tid0, int, int) {
    asm volatile("" : "+v"(tid0)); const int tid = tid0, lane = tid & 63, wid = __builtin_amdgcn_readfirstlane(tid >> 6);
    unsigned char* ws = a.ws;
    const int gw = blockIdx.x * 8 + wid, NGW = gridDim.x * 8;
    LAS float* scr = (LAS float*)(lds + wid * 16384);
    if (gw == 0) { const float* lq1 = (const float*)a.in[10] + layer * 64; const float* lk1 = (const float*)a.in[11] + layer * 64; const float* lq2 = (const float*)a.in[12] + layer * 64; const float* lk2 = (const float*)a.in[13] + layer * 64;
        const float lambda_init = 0.8f - 0.6f * expf(-0.3f * (float)layer); const float s1 = wave_sum(lq1[lane] * lk1[lane]), s2 = wave_sum(lq2[lane] * lk2[lane]);
        if (lane == 0) { ((float*)(ws + WS_LAM))[0] = expf(s1) - expf(s2) + lambda_init; ((float*)(ws + WS_LAM))[1] = 1.0f - lambda_init; } }
    const float* w_in = (const float*)a.in[3] + (size_t)layer * DMODEL * DIN;
    const float* w_merge = (const float*)a.in[21] + (size_t)layer * DMODEL * 3072;
    conv_items((bf16_t*)(ws + WS_WCAT), 1024, NCAT, [=](int n, const float*& cp, int& ld) {
        const int t = n >> 8, w = n & 255; ld = DIN; int col = -1;
        if (t < 2) col = (n >> 6) * 64 + rope_perm(n & 63);
        else if (t == 2) col = 512 + w;
        else if (t == 3) col = (w < 128) ? 768 + (w >> 6) * 64 + rope_perm(w & 63) : 896 + (w - 128);
        else if (t == 4) col = (w < 128) ? 1024 + (w >> 6) * 64 + rope_perm(w & 63) : 1152 + (w - 128);
        else if (t < 7) { const int p = n - 1280; col = 1304 + (p >> 6) * 64 + rope_perm(p & 63); }
        else if (t < 9) { const int p = n - 1792; col = 1816 + (p >> 6) * 64 + rope_perm(p & 63); }
        else if (t < 11) col = 2328 + (n - 2304);
        else if (t < 15) col = 2840 + (n - 2816);
        else if (t < 27) { ld = 3072; cp = w_merge + (n - 3840); return; }
        else col = (w < 24) ? 1280 + w : -1;
        cp = col >= 0 ? w_in + col : nullptr; }, scr, gw, NGW, lane);
#pragma unroll
    for (int br = 0; br < 3; ++br) { const float* wb = (const float*)a.in[18 + br] + (size_t)layer * 512 * 1024;
        conv_items((bf16_t*)(ws + WS_WBR) + (size_t)br * 1024 * 512, 512, 1024, [=](int n, const float*& cp, int& ld) { ld = 1024; cp = wb + n; }, scr, gw, NGW, lane); }
    { const float* wo = (const float*)a.in[23] + (size_t)layer * 1024 * 1024;
      conv_items((bf16_t*)(ws + WS_WOUT), 1024, 1024, [=](int n, const float*& cp, int& ld) { ld = 1024; cp = wo + n; }, scr, gw, NGW, lane); }
    { const float* w1 = (const float*)a.in[25] + (size_t)layer * 1024 * DFF; const float* w3 = (const float*)a.in[26] + (size_t)layer * 1024 * DFF;
      conv_items((bf16_t*)(ws + WS_W13), 1024, NFF13, [=](int n, const float*& cp, int& ld) { const int t = n >> 8, w = n & 255; ld = DFF; const long d31 = w3 - w1; cp = w1 + ((long)(t * 128 + (w & 127)) + ((w < 128) ? 0L : d31)); }, scr, gw, NGW, lane); }
    { const float* w2 = (const float*)a.in[27] + (size_t)layer * DFF * 1024;
      conv_items((bf16_t*)(ws + WS_W2), DFF, 1024, [=](int n, const float*& cp, int& ld) { ld = 1024; cp = w2 + n; }, scr, gw, NGW, lane); }
#pragma unroll
    for (int which = 0; which < 2; ++which) {
        const float* c1 = (const float*)a.in[which ? 8 : 5] + (size_t)layer * 2048 * 256; const float* c2 = (const float*)a.in[which ? 9 : 6] + (size_t)layer * 256 * 64;
        conv_items((bf16_t*)(ws + WS_WC1) + (size_t)which * 256 * 2048, 2048, 256, [=](int n, const float*& cp, int& ld) { ld = 256; cp = c1 + n; }, scr, gw, NGW, lane);
        conv_items((bf16_t*)(ws + WS_WC2) + (size_t)which * 64 * 256, 256, 64, [=](int n, const float*& cp, int& ld) { ld = 64; cp = c2 + (which ? n : rope_perm(n)); }, scr, gw, NGW, lane);
        const float* pos = (const float*)a.in[which ? 7 : 4] + (size_t)layer * 2048;
        for (int it = gw; it < 64; it += NGW) { const int jb = it & 3, kp = it >> 2; float s = 0.f;
#pragma unroll 8
            for (int k = kp * 128; k < kp * 128 + 128; ++k) s += pos[k] * c1[(size_t)k * 256 + jb * 64 + lane];
            ((float*)(ws + WS_BIAS1))[(which * 16 + kp) * 256 + jb * 64 + lane] = s; }
    }
    rms_rows_bf16(xin, (const float*)a.in[2] + (size_t)layer * DMODEL, (bf16_t*)(ws + WS_H64), gw, NGW, lane);
}

__device__ __forceinline__ void rope_table(const KA& a, int tid0) {
    asm volatile("" : "+v"(tid0)); const int tid = tid0; unsigned char* ws = a.ws;
    {
        const int* positions = (const int*)a.in[1]; float* cosT = (float*)(ws + WS_COS); float* sinT = (float*)(ws + WS_SIN);
        for (int e = blockIdx.x * 512 + tid; e < MTOK * 32; e += gridDim.x * 512) { const int m = e >> 5, i = e & 31;
            double pw = 1.0; for (int k = 0; k < i; ++k) pw *= 0.7498942093324559;
            const float inv = (float)pw; const float ang = (float)positions[m] * inv;
            const double ad = (double)ang; const double kq = __builtin_rint(ad * 0.6366197723675814);
            const double y = (ad - kq * 1.5707963267341256) - kq * 6.077100506506192e-11, z = y * y;
            const double sy = y + y * z * (-0.166666666416265235595 + z * (0.0083333293858894631756 + z * (-0.000198393348360966317347 + z * 0.0000027183114939898219064)));
            const double cy = 1.0 + z * (-0.499999997251031003120 + z * (0.0416666233237390631894 + z * (-0.00138867637746099294692 + z * 0.0000243904487962774090654)));
            const int qd = ((int)kq) & 3; const double sn = (qd == 0) ? sy : (qd == 1) ? cy : (qd == 2) ? -sy : -cy, cs = (qd == 0) ? cy : (qd == 1) ? -sy : (qd == 2) ? -cy : sy;
            cosT[e] = (float)cs; sinT[e] = (float)sn; }
    }
}

__device__ __forceinline__ void compress_unit(const KA& a, int unit, LAS unsigned char* lds, int tid0, int, int) {
    asm volatile("" : "+v"(tid0)); const int tid = tid0, lane = tid & 63, wid = __builtin_amdgcn_readfirstlane(tid >> 6);
    unsigned char* ws = a.ws;
    const int which = unit >> 7, b = (unit >> 5) & 3, g = (unit >> 4) & 1, n0 = (unit & 15) * 32;
    const bf16_t* src = (const bf16_t*)(ws + (which ? WS_VCMP : WS_KCMP));
    const bf16_t* W1t = (const bf16_t*)(ws + WS_WC1) + (size_t)which * 256 * 2048; const bf16_t* W2t = (const bf16_t*)(ws + WS_WC2) + (size_t)which * 64 * 256;
    const float* bias1 = (const float*)(ws + WS_BIAS1) + which * 16 * 256;
    constexpr int HST = 264; LAS bf16_t* H1 = (LAS bf16_t*)lds;
    const int fr = lane & 15, q = lane >> 4, j0 = 32 * wid;
    f32x4 acc[2][2];
#pragma unroll
    for (int i = 0; i < 2; ++i)
#pragma unroll
        for (int j = 0; j < 2; ++j) acc[i][j] = (f32x4){0.f, 0.f, 0.f, 0.f};
#pragma unroll 4
    for (int ks = 0; ks < 64; ++ks) { const int k0 = 32 * ks + 8 * q, l = k0 >> 6, d = k0 & 63; bf16x8 af[2], bfr[2];
#pragma unroll
        for (int mt = 0; mt < 2; ++mt) { int tok = 16 * (n0 + 16 * mt + fr) + l; tok = tok < SEQ ? tok : SEQ - 1; af[mt] = *(const bf16x8*)(src + ((size_t)b * SEQ + tok) * 128 + g * 64 + d); }
#pragma unroll
        for (int nt = 0; nt < 2; ++nt) bfr[nt] = *(const bf16x8*)(W1t + (size_t)(j0 + 16 * nt + fr) * 2048 + k0);
#pragma unroll
        for (int mt = 0; mt < 2; ++mt)
#pragma unroll
            for (int nt = 0; nt < 2; ++nt) acc[mt][nt] = mfma16(af[mt], bfr[nt], acc[mt][nt]);
    }
#pragma unroll
    for (int mt = 0; mt < 2; ++mt)
#pragma unroll
        for (int nt = 0; nt < 2; ++nt) { const int j = j0 + 16 * nt + fr; float bj = 0.f;
#pragma unroll
            for (int p = 0; p < 16; ++p) bj += bias1[p * 256 + j];
#pragma unroll
            for (int i = 0; i < 4; ++i) { const float h = pg8::gelu_tanh(acc[mt][nt][i] + bj); H1[(16 * mt + 4 * q + i) * HST + j] = (bf16_t)(pk2(h, 0.f) & 0xffffu); } }
    __syncthreads();
    { const int mt = wid >> 2, dt = wid & 3; f32x4 o = (f32x4){0.f, 0.f, 0.f, 0.f};
#pragma unroll
      for (int ks = 0; ks < 8; ++ks) { const bf16x8 af = *(const LAS bf16x8*)(H1 + (16 * mt + fr) * HST + 32 * ks + 8 * q); const bf16x8 bf = *(const bf16x8*)(W2t + (size_t)(16 * dt + fr) * 256 + 32 * ks + 8 * q); o = mfma16(af, bf, o); }
      const int bg = b * 2 + g, d = 16 * dt + fr, nb = n0 + 16 * mt + 4 * q;
      if (which == 0) { bf16_t* kc = (bf16_t*)(ws + WS_KC) + (size_t)bg * 512 * 64;
#pragma unroll
          for (int i = 0; i < 4; ++i) kc[(size_t)(nb + i) * 64 + d] = (nb + i < 511) ? (bf16_t)(pk2(o[i], 0.f) & 0xffffu) : (bf16_t)0; }
      else { bf16_t* vct = (bf16_t*)(ws + WS_VCT) + (size_t)bg * 64 * 512; if (nb + 3 >= 511) o[3] = 0.f;
          *(u32x2*)(vct + (size_t)d * 512 + nb) = (u32x2){pk2(o[0], o[1]), pk2(o[2], o[3])}; }
    }
    __syncthreads();
}

__device__ __forceinline__ void sgu_unit(const KA& a, int layer, int unit, LAS unsigned char* lds, int tid0, int, int, bf16_t* dstb) {
    asm volatile("" : "+v"(tid0)); const int tid = tid0, lane = tid & 63, wid = __builtin_amdgcn_readfirstlane(tid >> 6);
    unsigned char* ws = a.ws;
    const bf16_t* ub = (const bf16_t*)(ws + WS_U); const bf16_t* vb = (const bf16_t*)(ws + WS_V);
    const float* gain = (const float*)a.in[15] + (size_t)layer * 512; const float* wsp = (const float*)a.in[16] + (size_t)layer * 4 * 128 * 128; const float* bsp = (const float*)a.in[17] + (size_t)layer * 4 * 128;
    constexpr int VST = 144, UST = 136; LAS bf16_t* vL = (LAS bf16_t*)lds; LAS bf16_t* uL = (LAS bf16_t*)(lds + 128 * VST * 2); LAS float* rstat = (LAS float*)(lds + 128 * VST * 2 + 128 * UST * 2);
    typedef short v4i16_t __attribute__((ext_vector_type(4)));
    const size_t row0 = (size_t)unit * 128; const int fr = lane & 15, q = lane >> 4;
    { u32x4 x[16];
#pragma unroll
      for (int rr = 0; rr < 16; ++rr) x[rr] = *(const u32x4*)(vb + (row0 + wid * 16 + rr) * 512 + lane * 8);
#pragma unroll
      for (int rr = 0; rr < 16; ++rr) { float s = 0.f;
#pragma unroll
          for (int k = 0; k < 4; ++k) { const float lo = bflo(x[rr][k]), hi = bfhi(x[rr][k]); s += lo * lo + hi * hi; }
          s = wave_sum(s); if (lane == 0) rstat[wid * 16 + rr] = 1.0f / sqrtf(s * (1.0f / 512.0f) + EPS); } }
    __syncthreads();
    u32x4 xv[4], xu[4];
#pragma unroll
    for (int it = 0; it < 4; ++it) { const int idx = tid + 512 * it, s = idx >> 4, c8 = (idx & 15) * 8; xv[it] = *(const u32x4*)(vb + (row0 + s) * 512 + c8); xu[it] = *(const u32x4*)(ub + (row0 + s) * 512 + c8); }
#pragma unroll 1
    for (int g = 0; g < 4; ++g) {
        {
#pragma unroll
          for (int it = 0; it < 4; ++it) { const int idx = tid + 512 * it, s = idx >> 4, c8 = (idx & 15) * 8; const float rs = rstat[s];
              const f32x4 g0 = *(const f32x4*)(gain + g * 128 + c8), g1 = *(const f32x4*)(gain + g * 128 + c8 + 4);
              u32x4 o; o.x = pk2(bflo(xv[it].x) * rs * g0.x, bfhi(xv[it].x) * rs * g0.y); o.y = pk2(bflo(xv[it].y) * rs * g0.z, bfhi(xv[it].y) * rs * g0.w);
              o.z = pk2(bflo(xv[it].z) * rs * g1.x, bfhi(xv[it].z) * rs * g1.y); o.w = pk2(bflo(xv[it].w) * rs * g1.z, bfhi(xv[it].w) * rs * g1.w);
              *(LAS u32x4*)(vL + s * VST + c8) = o; *(LAS u32x4*)(uL + s * UST + c8) = xu[it]; } }
        __syncthreads();
        if (g < 3) {
#pragma unroll
            for (int it = 0; it < 4; ++it) { const int idx = tid + 512 * it, s = idx >> 4, c8 = (idx & 15) * 8; xv[it] = *(const u32x4*)(vb + (row0 + s) * 512 + (g + 1) * 128 + c8); xu[it] = *(const u32x4*)(ub + (row0 + s) * 512 + (g + 1) * 128 + c8); } }
        const int t0 = 16 * wid; f32x4 acc[8];
#pragma unroll
        for (int ct = 0; ct < 8; ++ct) acc[ct] = (f32x4){0.f, 0.f, 0.f, 0.f};
#pragma unroll
        for (int ks = 0; ks < 4; ++ks) { if (32 * ks <= t0 + 15) {
            const int t = t0 + fr, s0 = 32 * ks + 8 * q; const float* wr = wsp + ((size_t)g * 128 + t) * 128 + s0; const f32x4 w0 = *(const f32x4*)wr, w1 = *(const f32x4*)(wr + 4);
            float wv[8] = {w0.x, w0.y, w0.z, w0.w, w1.x, w1.y, w1.z, w1.w};
#pragma unroll
            for (int k = 0; k < 8; ++k) wv[k] = (s0 + k <= t) ? wv[k] : 0.f;
            const u32x4 ap = (u32x4){pk2(wv[0], wv[1]), pk2(wv[2], wv[3]), pk2(wv[4], wv[5]), pk2(wv[6], wv[7])}; const bf16x8 af = __builtin_bit_cast(bf16x8, ap);
            const LAS bf16_t* vp = vL + (s0 + (fr >> 2)) * VST + 4 * (fr & 3);
#pragma unroll
            for (int ct = 0; ct < 8; ++ct) { const v4i16_t b0 = __builtin_amdgcn_ds_read_tr16_b64_v4i16((LAS v4i16_t*)(vp + 16 * ct)), b1 = __builtin_amdgcn_ds_read_tr16_b64_v4i16((LAS v4i16_t*)(vp + 4 * VST + 16 * ct));
                const bf16x8 bf = (bf16x8){b0[0], b0[1], b0[2], b0[3], b1[0], b1[1], b1[2], b1[3]}; acc[ct] = mfma16(af, bf, acc[ct]); } } }
#pragma unroll
        for (int ct = 0; ct < 8; ++ct)
#pragma unroll
            for (int i = 0; i < 4; ++i) { const int t = t0 + 4 * q + i; LAS bf16_t* up = uL + t * UST + ct * 16 + fr; const float uval = __uint_as_float(((unsigned)*up) << 16);
                *up = (bf16_t)(pk2((acc[ct][i] + bsp[g * 128 + t]) * uval, 0.f) & 0xffffu); }
        LDS_WAIT();
#pragma unroll
        for (int it = 0; it < 4; ++it) { const int r = t0 + it * 4 + (lane >> 4), c8 = (lane & 15) * 8; *(u32x4*)(dstb + (row0 + r) * 512 + g * 128 + c8) = *(const LAS u32x4*)(uL + r * UST + c8); }
        __syncthreads();
    }
}

__device__ __forceinline__ float dpp_xor1(float v) { return __int_as_float(__builtin_amdgcn_update_dpp(0, __float_as_int(v), 0xB1, 0xF, 0xF, true)); }
__device__ __forceinline__ float dpp_xor2(float v) { return __int_as_float(__builtin_amdgcn_update_dpp(0, __float_as_int(v), 0x4E, 0xF, 0xF, true)); }
__device__ __forceinline__ void cmp_phase(const KA& a, LAS unsigned char* lds, int tid0, int, int) {
    asm volatile("" : "+v"(tid0)); const int tid = tid0, lane = tid & 63, wid = __builtin_amdgcn_readfirstlane(tid >> 6);
    unsigned char* ws = a.ws;
    const bf16_t* qa = (const bf16_t*)(ws + WS_QA); bf16_t* ocmp = (bf16_t*)(ws + WS_OCMP); u32x4* selp = (u32x4*)(ws + WS_SEL);
    constexpr int KST = 72, VST = 516;
    LAS bf16_t* kcL = (LAS bf16_t*)lds; LAS bf16_t* vcL = (LAS bf16_t*)(lds + 512 * KST * 2); LAS float* scr = (LAS float*)(lds + 512 * KST * 2 + 64 * VST * 2) + wid * 512;
    const int fr = lane & 15, rq = lane >> 4, tok = fr >> 2, head = fr & 3;
    for (int v = blockIdx.x; v < 256; v += gridDim.x) {
        const int bg = v >> 5, b = bg >> 1, g = bg & 1, chunk = v & 31;
        __syncthreads();
        const bf16_t* kcg = (const bf16_t*)(ws + WS_KC) + (size_t)bg * 512 * 64; const bf16_t* vcg = (const bf16_t*)(ws + WS_VCT) + (size_t)bg * 64 * 512;
        for (int it = tid; it < 4096; it += 512) { const int r = it >> 3, c = it & 7; *(LAS u32x4*)(kcL + r * KST + c * 8) = *(const u32x4*)(kcg + r * 64 + c * 8); }
        for (int it = tid; it < 4096; it += 512) { const int r = it >> 6, c = it & 63; const u32x4 x = *(const u32x4*)(vcg + r * 512 + c * 8); LAS u32x2* d = (LAS u32x2*)(vcL + r * VST + c * 8); d[0] = (u32x2){x.x, x.y}; d[1] = (u32x2){x.z, x.w}; }
        __syncthreads();
        bf16x8 qnx[2];
        { const int t0n = chunk * 32 + wid * 4; const size_t grown = (size_t)b * SEQ + t0n + tok;
#pragma unroll
          for (int ks = 0; ks < 2; ++ks) qnx[ks] = *(const bf16x8*)(qa + grown * 512 + (4 * g + head) * 64 + 32 * ks + 8 * rq); }
        for (int it = 0; it < 8; ++it) {
            const int t0 = (it * 32 + chunk) * 32 + wid * 4, t = t0 + tok; const size_t grow = (size_t)b * SEQ + t;
            bf16x8 qf[2]; qf[0] = qnx[0]; qf[1] = qnx[1];
            if (it < 7) { const size_t grown = (size_t)b * SEQ + ((it + 1) * 32 + chunk) * 32 + wid * 4 + tok;
#pragma unroll
                for (int ks = 0; ks < 2; ++ks) qnx[ks] = *(const bf16x8*)(qa + grown * 512 + (4 * g + head) * 64 + 32 * ks + 8 * rq); }
            const int nmax = (t >= 31) ? ((t - 31) >> 4) : -1, nmw = (t0 + 3 >= 31) ? ((t0 + 3 - 31) >> 4) : -1, ntc = (nmw >> 4) + 1;
            float m = -INFINITY, l = 0.f;
#pragma unroll 2
            for (int nt = 0; nt < ntc; ++nt) { const bf16x8 a0 = *(const LAS bf16x8*)(kcL + (16 * nt + fr) * KST + 8 * rq), a1 = *(const LAS bf16x8*)(kcL + (16 * nt + fr) * KST + 32 + 8 * rq);
                f32x4 sv = mfma16(a0, qf[0], (f32x4){0.f, 0.f, 0.f, 0.f}); sv = mfma16(a1, qf[1], sv);
#pragma unroll
                for (int i = 0; i < 4; ++i) sv[i] = (16 * nt + 4 * rq + i <= nmax) ? sv[i] : -INFINITY;
                const float mn = fmaxf(fmaxf(m, fmaxf(sv[0], sv[1])), fmaxf(sv[2], sv[3])), ms = (mn == -INFINITY) ? 0.f : mn;
                l = l * __builtin_amdgcn_exp2f(m - ms) + ((__builtin_amdgcn_exp2f(sv[0] - ms) + __builtin_amdgcn_exp2f(sv[1] - ms)) + (__builtin_amdgcn_exp2f(sv[2] - ms) + __builtin_amdgcn_exp2f(sv[3] - ms)));
                m = mn; }
            float M = fmaxf(m, __shfl_xor(m, 16)); M = fmaxf(M, __shfl_xor(M, 32)); const float Ms = (M == -INFINITY) ? 0.f : M;
            l = l * __builtin_amdgcn_exp2f(m - Ms); l += __shfl_xor(l, 16); l += __shfl_xor(l, 32);
            const float inv = l > 0.f ? 1.0f / l : 0.f;
            f32x4 O[4];
#pragma unroll
            for (int dt = 0; dt < 4; ++dt) O[dt] = (f32x4){0.f, 0.f, 0.f, 0.f};
            float zprev = 0.f;
#pragma unroll
            for (int z8 = 0; z8 < 8; ++z8) scr[z8 * 64 + lane] = 0.f;
            const int kkc = (ntc / 2 + 1) < 16 ? (ntc / 2 + 1) : 16;
#pragma unroll 1
            for (int kk = 0; kk < kkc; ++kk) { const int nt0 = 2 * kk; f32x4 pp[2];
#pragma unroll
                for (int h2 = 0; h2 < 2; ++h2) { const int nt = nt0 + h2; pp[h2] = (f32x4){0.f, 0.f, 0.f, 0.f};
                    if (nt < ntc) { const bf16x8 a0 = *(const LAS bf16x8*)(kcL + (16 * nt + fr) * KST + 8 * rq), a1 = *(const LAS bf16x8*)(kcL + (16 * nt + fr) * KST + 32 + 8 * rq);
                        f32x4 sv = mfma16(a0, qf[0], (f32x4){0.f, 0.f, 0.f, 0.f}); sv = mfma16(a1, qf[1], sv);
#pragma unroll
                        for (int i = 0; i < 4; ++i) pp[h2][i] = (16 * nt + 4 * rq + i <= nmax) ? __builtin_amdgcn_exp2f(sv[i] - Ms) * inv : 0.f; } }
                if (nt0 < ntc) { const u32x4 ap = (u32x4){pk2(pp[0][0], pp[0][1]), pk2(pp[0][2], pp[0][3]), pk2(pp[1][0], pp[1][1]), pk2(pp[1][2], pp[1][3])}; const bf16x8 af = __builtin_bit_cast(bf16x8, ap);
#pragma unroll
                    for (int dt = 0; dt < 4; ++dt) { const LAS bf16_t* vp = vcL + (16 * dt + fr) * VST + 16 * nt0 + 4 * rq; const u32x2 p0 = *(const LAS u32x2*)vp, p1 = *(const LAS u32x2*)(vp + 16);
                        const u32x4 bp = (u32x4){p0.x, p0.y, p1.x, p1.y}; O[dt] = mfma16(af, __builtin_bit_cast(bf16x8, bp), O[dt]); } }
#pragma unroll
                for (int h2 = 0; h2 < 2; ++h2) { const int nt = nt0 + h2;
                    float s4 = (pp[h2][0] + pp[h2][1]) + (pp[h2][2] + pp[h2][3]), s3 = pp[h2][3];
                    s4 += dpp_xor1(s4); s4 += dpp_xor2(s4); s3 += dpp_xor1(s3); s3 += dpp_xor2(s3);
                    const float z = __shfl(s3, (lane - 16) & 63);
                    const float imp = s4 + (rq > 0 ? z : zprev); zprev = z;
                    if (head == 0) scr[tok * 128 + 4 * nt + rq] = imp; }
            }
#pragma unroll
            for (int dt = 0; dt < 4; ++dt)
#pragma unroll
                for (int i = 0; i < 4; ++i) ocmp[((size_t)b * SEQ + t0 + rq) * 512 + (4 * g + i) * 64 + 16 * dt + fr] = (bf16_t)(pk2(O[dt][i], 0.f) & 0xffffu);
            LDS_WAIT();
            {
                unsigned k0[4], k1[4], T[4]; int Rr[4];
#pragma unroll
                for (int tk = 0; tk < 4; ++tk) { const int cu = (t0 + tk) >> 6; const float a0 = scr[tk * 128 + lane], a1 = scr[tk * 128 + 64 + lane]; const int j1 = lane + 64;
                    const bool f0 = (lane == 0) || (lane == cu) || (lane == cu - 1), f1 = (j1 == cu) || (j1 == cu - 1);
                    const bool c0 = (lane <= cu) && !f0, c1 = (j1 <= cu) && !f1;
                    k0[tk] = c0 ? (__float_as_uint(a0) | 0x80000000u) : 0u; k1[tk] = c1 ? (__float_as_uint(a1) | 0x80000000u) : 0u;
                    T[tk] = 0x80000000u; Rr[tk] = 16 - ((cu == 0) ? 1 : (cu == 1) ? 2 : 3); }
#pragma unroll 1
                for (int bit = 30; bit >= 0; --bit) {
#pragma unroll
                    for (int tk = 0; tk < 4; ++tk) { const unsigned tr = T[tk] | (1u << bit);
                        const int cnt = __popcll(__ballot(k0[tk] >= tr)) + __popcll(__ballot(k1[tk] >= tr)); T[tk] = (cnt >= Rr[tk]) ? tr : T[tk]; } }
#pragma unroll
                for (int tk = 0; tk < 4; ++tk) { const int tt = t0 + tk, cu = tt >> 6; const int j1 = lane + 64;
                    const bool f0 = (lane == 0) || (lane == cu) || (lane == cu - 1), f1 = (j1 == cu) || (j1 == cu - 1);
                    const unsigned Tt = T[tk];
                    const unsigned long long g0 = __ballot(k0[tk] > Tt), g1 = __ballot(k1[tk] > Tt), e0 = __ballot(k0[tk] == Tt), e1 = __ballot(k1[tk] == Tt);
                    const int need = Rr[tk] - (__popcll(g0) + __popcll(g1)), need1 = need - __popcll(e0);
                    const int p0 = __builtin_amdgcn_mbcnt_hi((unsigned)(e0 >> 32), __builtin_amdgcn_mbcnt_lo((unsigned)e0, 0u)), p1 = __builtin_amdgcn_mbcnt_hi((unsigned)(e1 >> 32), __builtin_amdgcn_mbcnt_lo((unsigned)e1, 0u));
                    const bool s0 = (k0[tk] > Tt) || (k0[tk] == Tt && p0 < need), s1 = (k1[tk] > Tt) || (k1[tk] == Tt && p1 < need1);
                    const unsigned long long m0 = __ballot(f0 || s0), m1 = __ballot(f1 || s1);
                    if (lane == 0) selp[((size_t)b * SEQ + tt) * 2 + g] = (u32x4){(unsigned)m0, (unsigned)(m0 >> 32), (unsigned)m1, (unsigned)(m1 >> 32)}; }
            }
            LDS_WAIT();
        }
    }
    __syncthreads();
}

__device__ __forceinline__ void diff_post(const KA& a, int layer, float lambda_init, int tid0) {
    asm volatile("" : "+v"(tid0)); const int lane = tid0 & 63, wid = __builtin_amdgcn_readfirstlane(tid0 >> 6);
    unsigned char* ws = a.ws; const int gw = blockIdx.x * 8 + wid, NGW = gridDim.x * 8;
    const float* lq1 = (const float*)a.in[10] + layer * 64; const float* lk1 = (const float*)a.in[11] + layer * 64; const float* lq2 = (const float*)a.in[12] + layer * 64; const float* lk2 = (const float*)a.in[13] + layer * 64;
    const float s1 = wave_sum(lq1[lane] * lk1[lane]), s2 = wave_sum(lq2[lane] * lk2[lane]);
    const float lam = expf(s1) - expf(s2) + lambda_init, post = 1.0f - lambda_init;
    const bf16_t* dO = (const bf16_t*)(ws + WS_H64); bf16_t* ob = (bf16_t*)(ws + WS_QB);
    const int h = lane >> 4, e0 = (lane & 15) * 8; const float* sg = (const float*)a.in[14] + layer * 128 + e0;
    const f32x4 g0 = *(const f32x4*)sg, g1 = *(const f32x4*)(sg + 4);
    for (int m0 = gw; m0 < MTOK; m0 += 4 * NGW) {
        u32x4 o1[4], o2[4];
#pragma unroll
        for (int r = 0; r < 4; ++r) { const int m = (m0 + r * NGW < MTOK) ? m0 + r * NGW : m0; o1[r] = *(const u32x4*)(dO + (size_t)m * 1024 + h * 256 + e0); o2[r] = *(const u32x4*)(dO + (size_t)m * 1024 + h * 256 + 128 + e0); }
#pragma unroll
        for (int r = 0; r < 4; ++r) { const int m = (m0 + r * NGW < MTOK) ? m0 + r * NGW : m0; float v[8]; float ss = 0.f;
#pragma unroll
            for (int k = 0; k < 4; ++k) { v[2 * k] = bflo(o1[r][k]) - lam * bflo(o2[r][k]); v[2 * k + 1] = bfhi(o1[r][k]) - lam * bfhi(o2[r][k]); ss += v[2 * k] * v[2 * k] + v[2 * k + 1] * v[2 * k + 1]; }
            ss += __shfl_xor(ss, 1); ss += __shfl_xor(ss, 2); ss += __shfl_xor(ss, 4); ss += __shfl_xor(ss, 8);
            const float rs = post / sqrtf(ss * (1.0f / 128.0f) + EPS);
            *(u32x4*)(ob + (size_t)m * 512 + h * 128 + e0) = (u32x4){pk2(v[0] * rs * g0.x, v[1] * rs * g0.y), pk2(v[2] * rs * g0.z, v[3] * rs * g0.w), pk2(v[4] * rs * g1.x, v[5] * rs * g1.y), pk2(v[6] * rs * g1.z, v[7] * rs * g1.w)}; }
    }
}

#define XB_TMO      128
#define XB_XCNT(j)  (256  + 64 * (j))
#define XB_XSUB(j)  (1280 + 64 * (j))
#define XB_XGEN(j)  (2304 + 64 * (j))
#define XB_TOP      3328
#define XB_TOPGEN   3392
#define XCD_BAR_WORDS 3456
#define XB_SPIN_CAP (1u << 18)

__device__ __forceinline__ unsigned xb_ld(unsigned* p)              { return __hip_atomic_load(p, __ATOMIC_RELAXED, __HIP_MEMORY_SCOPE_AGENT); }
__device__ __forceinline__ unsigned xb_add(unsigned* p, unsigned v) { return __hip_atomic_fetch_add(p, v, __ATOMIC_RELAXED, __HIP_MEMORY_SCOPE_AGENT); }
__device__ __forceinline__ unsigned xb_xcc_id() { return (unsigned)__builtin_amdgcn_s_getreg((3 << 11) | 20) & 0xFu; }
#define XB_SPIN(cond, bar) do { unsigned _sp = 0; while (cond) { __builtin_amdgcn_s_sleep(1); \
    if ((++_sp & 255u) == 0u) { if (xb_ld(&(bar)[XB_TMO])) break; if (_sp > XB_SPIN_CAP) { atomicAdd(&(bar)[XB_TMO], 1u); break; } } } } while (0)

struct XcdBarrier {
    unsigned* bar; unsigned x;
    volatile LAS unsigned* st;
};

__device__ __forceinline__ XcdBarrier xcd_barrier_post(unsigned* bar, volatile LAS unsigned* st) {
    XcdBarrier b; b.bar = bar; b.x = xb_xcc_id(); b.st = st;
    if (threadIdx.x == 0) (void)xb_add(&bar[XB_XCNT(b.x)], 1u);
    return b;
}
__device__ __forceinline__ void xcd_barrier_complete(unsigned* bar, unsigned x, unsigned& nloc, unsigned& nx) {
    const unsigned G = gridDim.x * gridDim.y * gridDim.z;
    unsigned sum, cnt, mine, sp = 0u;
    for (;;) {
        sum = 0u; cnt = 0u; mine = 0u;
#pragma unroll
        for (unsigned j = 0; j < 16; ++j) { const unsigned c = xb_ld(&bar[XB_XCNT(j)]); sum += c; cnt += (c > 0u) ? 1u : 0u; mine = (j == x) ? c : mine; }
        if (sum == G) break;
        __builtin_amdgcn_s_sleep(1);
        if ((++sp & 255u) == 0u) { if (xb_ld(&bar[XB_TMO])) break; if (sp > XB_SPIN_CAP) { atomicAdd(&bar[XB_TMO], 1u); break; } }
    }
    nloc = mine > 0u ? mine : 1u; nx = cnt > 0u ? cnt : 1u;
}

__device__ __forceinline__ void xcd_barrier(const XcdBarrier& b) {
    asm volatile("s_waitcnt vmcnt(0)" ::: "memory");
    __syncthreads();
    if (threadIdx.x == 0) {
        unsigned* bar = b.bar;
        __builtin_amdgcn_s_waitcnt(0);
        unsigned nloc = b.st[0], nx = b.st[1];
        if (nloc == 0u) { xcd_barrier_complete(bar, b.x, nloc, nx); b.st[0] = nloc; b.st[1] = nx; }
        const unsigned old = xb_add(&bar[XB_XSUB(b.x)], 1u);
        const unsigned gen = old / nloc;
        if (old + 1u == (gen + 1u) * nloc) {
            __builtin_amdgcn_fence(__ATOMIC_RELEASE, "agent");
            asm volatile("s_waitcnt vmcnt(0)" ::: "memory");
            const unsigned og = xb_add(&bar[XB_TOP], 1u);
            const unsigned tg = og / nx;
            if (og + 1u == (tg + 1u) * nx) xb_add(&bar[XB_TOPGEN], 1u);
            else XB_SPIN(xb_ld(&bar[XB_TOPGEN]) == tg, bar);
            __builtin_amdgcn_fence(__ATOMIC_ACQUIRE, "agent");
            xb_add(&bar[XB_XGEN(b.x)], 1u);
            asm volatile("s_waitcnt vmcnt(0)" ::: "memory");
        } else {
            XB_SPIN(xb_ld(&bar[XB_XGEN(b.x)]) == gen, bar);
            __builtin_amdgcn_fence(__ATOMIC_ACQUIRE, "agent");
            asm volatile("s_waitcnt vmcnt(0)" ::: "memory");
        }
    }
    __syncthreads();
}

#ifndef PHM
#define PHM 0x7df
#endif
#ifndef DBL
#define DBL 0
#endif
#define GSYNC() do { xcd_barrier(bar); if ((DBL >> 15) & 1) xcd_barrier(bar); } while (0)
#define NREP(bit) ((((DBL) >> (bit)) & 1) ? 2 : 1)
#define PHASE_WS const KA a = make_ka(); unsigned char* ws = a.ws; bf16_t* H64 = (bf16_t*)(ws + WS_H64); const float* cosT = (const float*)(ws + WS_COS); const float* sinT = (const float*)(ws + WS_SIN); (void)H64; (void)cosT; (void)sinT;
template <int layer> __device__ __forceinline__ void run_layer(LAS unsigned char* lds, unsigned char* lds_raw, const XcdBarrier& bar, int tid, int lane, int wid, int G, int bx) {
        const float lambda_init = 0.8f - 0.6f * expf(-0.3f * (float)layer);
#if (PHM >> 0) & 1
_Pragma("unroll 1")
        for (int rep_ = 0; rep_ < NREP(0); ++rep_) {
        { PHASE_WS const float* xin = layer == 0 ? (const float*)a.in[0] : (const float*)a.out; phase0(a, layer, xin, lds, tid, lane, wid); }
        if (layer == 0 && rep_ == 0) cg::this_grid().sync();
        else GSYNC(); }
#endif
#if (PHM >> 1) & 1
_Pragma("unroll 1")
        for (int rep_ = 0; rep_ < NREP(1); ++rep_) {
        { PHASE_WS
        { pg8::Gemm g{H64, (const bf16_t*)(ws + WS_WCAT), MTOK, NCAT, 1024}; pg8::StaticOrder S; S.init(MTOK, NCAT, G, bx);
          pg8::EpiG1 E{(bf16_t*)(ws + WS_QA), (bf16_t*)(ws + WS_KCMP), (bf16_t*)(ws + WS_VCMP), (bf16_t*)(ws + WS_KSLC), (bf16_t*)(ws + WS_VSLC), (bf16_t*)(ws + WS_KWIN), (bf16_t*)(ws + WS_VWIN),
                       (bf16_t*)(ws + WS_QB), (bf16_t*)(ws + WS_KB), (bf16_t*)(ws + WS_VB), (bf16_t*)(ws + WS_U), (bf16_t*)(ws + WS_V), ws + WS_GATES, (float*)(ws + WS_GA),
                       (const float*)a.in[22] + (size_t)layer * 3072, cosT, sinT, C2};
          pg8::gemm_phase<pg8::EpiG1, pg8::StaticOrder, true, true>(lds, g, S, E); }
        }
        GSYNC(); }
#endif
#if (PHM >> 2) & 1
        { PHASE_WS
#ifndef NO_CMPR
_Pragma("unroll 1")
        for (int rep_ = 0; rep_ < NREP(11); ++rep_)
        for (int u = bx; u < 256; u += G) compress_unit(a, u, lds, tid, lane, wid);
#endif
#ifndef NO_SGU
        if (((DBL >> 14) & 1) && layer == 0) for (int u = bx; u < 256; u += G) sgu_unit(a, layer, u, lds, tid, lane, wid, (bf16_t*)a.out);
        for (int u = bx; u < 256; u += G) sgu_unit(a, layer, u, lds, tid, lane, wid, (bf16_t*)(ws + WS_U));
#endif
#ifndef NO_SWA
        { attn_body::AArgs A{}; A.Q = (const attn_body::bf16*)(ws + WS_QA); A.K = (const attn_body::bf16*)(ws + WS_KWIN); A.V = (const attn_body::bf16*)(ws + WS_VWIN); A.O = (attn_body::bf16*)(ws + WS_OWIN);
          A.qp = 512; A.kp = 128; A.vp = 128; A.op = 512; A.cosT = cosT; A.sinT = sinT;
_Pragma("unroll 1")
          for (int rep_ = 0; rep_ < NREP(12); ++rep_)
          for (int u = bx; u < 1024; u += G) { const int xcd = u & 7, j = u >> 3, b = xcd >> 1, h = 4 * (xcd & 1) + (j & 3), qb = j >> 2;
              attn_body::attn_unit<1, 8>(b, h * 64, (h >> 2) * 64, (h >> 2) * 64, h * 64, h, h >> 2, qb, A, (char*)lds_raw); } }
#endif
        }
        GSYNC();
#endif
#if (PHM >> 3) & 1
_Pragma("unroll 1")
        for (int rep_ = 0; rep_ < NREP(3); ++rep_) {
        { PHASE_WS cmp_phase(a, lds, tid, lane, wid); }
        GSYNC(); }
#endif
#if (PHM >> 4) & 1
        { PHASE_WS
        for (int v = bx; v < 256; v += G) {
#ifndef NO_DIFF
            { attn_body::AArgs A{}; A.Q = (const attn_body::bf16*)(ws + WS_QB); A.K = (const attn_body::bf16*)(ws + WS_KB); A.V = (const attn_body::bf16*)(ws + WS_VB); A.O = (attn_body::bf16*)H64;
              A.qp = 512; A.kp = 512; A.vp = 512; A.op = 1024; A.subln = (const float*)a.in[14] + layer * 128; A.ob = (attn_body::bf16*)(ws + WS_QB); A.lamp = (const float*)(ws + WS_LAM);
              const int xcd = v & 7, j = v >> 3, s = j & 15, b = xcd >> 1, hd = 2 * (xcd & 1) + (j >> 4);
#pragma unroll 1
              for (int i = 0; i < 4 * NREP(13); ++i) { const int qb = (i & 2) ? s : 31 - s; const int mp = 2 * hd + (i & 1);
                  attn_body::attn_unit<3, 8>(b, mp * 64, mp * 64, hd * 128, mp * 128, 0, 0, qb, A, (char*)lds_raw, (i & 1) != 0); } }
#endif
#ifndef NO_SLC
            { attn_body::AArgs A{}; A.Q = (const attn_body::bf16*)(ws + WS_QA); A.K = (const attn_body::bf16*)(ws + WS_KSLC); A.V = (const attn_body::bf16*)(ws + WS_VSLC); A.O = (attn_body::bf16*)(ws + WS_QA);
              A.qp = 512; A.kp = 128; A.vp = 128; A.op = 512; A.cosT = cosT; A.sinT = sinT; A.sel = (const attn_body::u32x4*)(ws + WS_SEL);
              A.ocmp = (const attn_body::bf16*)(ws + WS_OCMP); A.owin = (const attn_body::bf16*)(ws + WS_OWIN); A.ga = (const float*)(ws + WS_GA);
              const int xcd = v & 7, j = v >> 3, s = j & 7, b = xcd >> 1, h = 4 * (xcd & 1) + (j >> 3);
              if (((DBL >> 17) & 1) && layer == 0) { attn_body::AArgs B_ = A; B_.O = (attn_body::bf16*)a.out;
#pragma unroll 1
                  for (int i = 0; i < 4; ++i) { const int k = 3 - i; const int qb = (k & 1) ? 16 * (k >> 1) + 15 - s : 16 * (k >> 1) + s;
                      attn_body::attn_unit<0, 8>(b, h * 64, (h >> 2) * 64, (h >> 2) * 64, h * 64, h, h >> 2, qb, B_, (char*)lds_raw); } }
#pragma unroll 1
              for (int i = 0; i < 4 + ((((DBL >> 16) & 1) && layer == 0) ? 4 : 0); ++i) { const int k = 3 - (i & 3); const int qb = (k & 1) ? 16 * (k >> 1) + 15 - s : 16 * (k >> 1) + s;
                  if (((DBL >> 16) & 1) && layer == 0) A.O = (i < 4) ? (attn_body::bf16*)a.out : (attn_body::bf16*)(ws + WS_QA);
                  attn_body::attn_unit<2, 8>(b, h * 64, (h >> 2) * 64, (h >> 2) * 64, h * 64, h, h >> 2, qb, A, (char*)lds_raw); } }
#endif
        }
        }
        GSYNC();
#endif
#if (PHM >> 5) & 1
        { PHASE_WS diff_post(a, layer, lambda_init, tid); }
        GSYNC();
#endif
#if (PHM >> 6) & 1
_Pragma("unroll 1")
        for (int rep_ = 0; rep_ < NREP(6); ++rep_) {
        { PHASE_WS
        { pg8::Gemm g{(const bf16_t*)(ws + WS_QA), (const bf16_t*)(ws + WS_WBR), MTOK, 1024, 512}; pg8::BranchOrder S; S.S.init(MTOK, 1024, G, bx);
          pg8::EpiBranch E{ws + WS_GATES, H64};
          pg8::gemm_phase<pg8::EpiBranch, pg8::BranchOrder, true, true>(lds, g, S, E); }
        }
        GSYNC(); }
#endif
#if (PHM >> 7) & 1
        { PHASE_WS
        { pg8::Gemm g{H64, (const bf16_t*)(ws + WS_WOUT), MTOK, 1024, 1024}; pg8::StaticOrder S; S.init(MTOK, 1024, G, bx);
          const float* xin = layer == 0 ? (const float*)a.in[0] : (const float*)a.out; pg8::EpiResid E{xin, a.out};
          pg8::gemm_phase<pg8::EpiResid, pg8::StaticOrder, true, true>(lds, g, S, E); }
        }
        GSYNC();
#endif
#if (PHM >> 8) & 1
_Pragma("unroll 1")
        for (int rep_ = 0; rep_ < NREP(8); ++rep_) {
        { PHASE_WS
        rms_rows_bf16(a.out, (const float*)a.in[24] + (size_t)layer * DMODEL, H64, bx * 8 + wid, G * 8, lane);
        }
        GSYNC(); }
#endif
#if (PHM >> 9) & 1
_Pragma("unroll 1")
        for (int rep_ = 0; rep_ < NREP(9); ++rep_) {
        { PHASE_WS
        { pg8::Gemm g{H64, (const bf16_t*)(ws + WS_W13), MTOK, NFF13, 1024}; pg8::StaticOrder S; S.init(MTOK, NFF13, G, bx);
          pg8::EpiSwiGLU E{(bf16_t*)(ws + WS_HID)};
          pg8::gemm_phase<pg8::EpiSwiGLU, pg8::StaticOrder, true, true>(lds, g, S, E); }
        }
        GSYNC(); }
#endif
#if (PHM >> 10) & 1
        { PHASE_WS
        { pg8::Gemm g{(const bf16_t*)(ws + WS_HID), (const bf16_t*)(ws + WS_W2), MTOK, 1024, DFF}; pg8::StaticOrder S; S.init(MTOK, 1024, G, bx);
          pg8::EpiResid E{a.out, a.out};
          pg8::gemm_phase<pg8::EpiResid, pg8::StaticOrder, true, true>(lds, g, S, E); }
        }
        GSYNC();
#endif
}

__global__ void __launch_bounds__(512, 2) fwd_kernel(KArgs kargs_) {
    extern __shared__ __attribute__((aligned(16))) unsigned char lds_raw[];
    LAS unsigned char* lds = (LAS unsigned char*)lds_raw;
    cg::grid_group grid = cg::this_grid();
    const int tid = threadIdx.x, lane = tid & 63, wid = __builtin_amdgcn_readfirstlane(tid >> 6);
    const int G = gridDim.x, bx = blockIdx.x;
    if (tid < 2) ((LAS unsigned*)(lds + LDS_BARW))[tid] = 0u;
    __syncthreads();
    XcdBarrier bar;
    { PHASE_WS bar = xcd_barrier_post((unsigned*)(ws + WS_BAR), (volatile LAS unsigned*)(lds + LDS_BARW)); rope_table(a, tid); }
    run_layer<0>(lds, lds_raw, bar, tid, lane, wid, G, bx);
    run_layer<1>(lds, lds_raw, bar, tid, lane, wid, G, bx);
    { PHASE_WS rms_rows_f32(a.out, (const float*)a.in[28], bx * 8 + wid, G * 8, lane); }
}

extern "C" void kernel_launch(void* const* d_in, const int* in_sizes, int n_in, void* d_out, int out_size, void* d_ws, size_t ws_size, hipStream_t stream) {
    static int grid = 0;
    if (grid == 0) {
        if (n_in != 29 || out_size != MTOK * DMODEL || ws_size < WS_END) { fprintf(stderr, "kernel_launch: unexpected shapes (n_in %d out %d ws %zu)\n", n_in, out_size, ws_size); grid = -1; return; }
        int dev = 0, cus = 0, per_cu = 0;
        hipGetDevice(&dev); hipDeviceGetAttribute(&cus, hipDeviceAttributeMultiprocessorCount, dev);
        if (hipFuncSetAttribute((const void*)fwd_kernel, hipFuncAttributeMaxDynamicSharedMemorySize, LDS_BYTES) != hipSuccess) { fprintf(stderr, "kernel_launch: hipFuncSetAttribute failed\n"); grid = -1; return; }
        if (hipOccupancyMaxActiveBlocksPerMultiprocessor(&per_cu, (const void*)fwd_kernel, 512, LDS_BYTES) != hipSuccess || per_cu < 1) { fprintf(stderr, "kernel_launch: occupancy query gave %d\n", per_cu); per_cu = 1; }
        (void)hipGetLastError();
        grid = cus * 1;
        if (grid > 256) grid = 256;
    }
    if (grid < 0) return;
    if (hipMemsetAsync((char*)d_ws + WS_BAR, 0, WS_BAR_BYTES, stream) != hipSuccess) { fprintf(stderr, "kernel_launch: memset failed\n"); return; }
    KArgs a{};
    for (int i = 0; i < 29; ++i) a.in[i] = d_in[i];
    a.out = (float*)d_out; a.ws = (unsigned char*)d_ws;
    void* args[] = {&a};
    hipError_t e = hipLaunchCooperativeKernel((const void*)fwd_kernel, dim3(grid), dim3(512), args, LDS_BYTES, stream);
    if (e != hipSuccess) fprintf(stderr, "cooperative launch failed: %s (grid %d)\n", hipGetErrorString(e), grid);
}
```
